# Optimizing an MI355X kernel written in HIP

```python
import math
import functools
import jax
import jax.numpy as jnp
from jax import lax
import numpy as np

D_MODEL = 1024
BATCH = 4
SEQ = 4096
DEPTH = 4
DEC_BATCH = 128
DEC_SEQ = 4
PAST_LEN = 8192
PAGE_SIZE = 128

D_MIX = D_MODEL
HEAD_DIM = 64
N_HEADS = (D_MIX // 2) // HEAD_DIM
N_KV_HEADS = 2
KV_GROUP = N_HEADS // N_KV_HEADS
D_ATTN = N_HEADS * HEAD_DIM
D_KV = N_KV_HEADS * HEAD_DIM
WINDOW = 128
ROPE_THETA = 10000.0
D_SSM = D_MIX // 4
SSM_GROUP = 16
N_SSM_GROUPS = D_SSM // SSM_GROUP
SSM_STATE = 64
D_LRU = D_MIX // 4
N_LRU_BLOCKS = 4
LRU_BLOCK = D_LRU // N_LRU_BLOCKS
LRU_CONV = 4
LRU_C = 8.0
D_FF = 11 * D_MODEL // 4
FFN_CONV = 3
D_IN = D_ATTN + 2 * D_KV + D_SSM + 2 * D_LRU
N_MOD = 6
EPS = 1e-6

kernel_name = 'hymba_s5_swa_rglru_convffn_step'


def rms_norm(x, w):
    xf = x.astype(jnp.float32)
    y = xf * lax.rsqrt(jnp.mean(xf * xf, axis=-1, keepdims=True) + EPS)
    return (y * w.astype(jnp.float32)).astype(x.dtype)


def rotary(x, pos):
    half = HEAD_DIM // 2
    inv = ROPE_THETA ** (-jnp.arange(half, dtype=jnp.float32) / half)
    ang = pos[:, None] * inv[None, :]
    cos = jnp.cos(ang)[None, :, None, :]
    sin = jnp.sin(ang)[None, :, None, :]
    xf = x.astype(jnp.float32)
    x1, x2 = xf[..., :half], xf[..., half:]
    return jnp.concatenate([x1 * cos - x2 * sin, x2 * cos + x1 * sin], axis=-1).astype(x.dtype)


def causal_dwconv(x, buf, w, b):
    k = w.shape[0]
    t = x.shape[1]
    xp = jnp.concatenate([buf.astype(x.dtype), x], axis=1)
    y = b + sum(w[j] * xp[:, j:j + t] for j in range(k))
    return y.astype(x.dtype), xp[:, t:]


def linear_recurrence(a, b, h0):
    b = b.at[:, 0].add(a[:, 0] * h0)

    def combine(l, r):
        return l[0] * r[0], r[0] * l[1] + r[1]

    _, h = lax.associative_scan(combine, (a, b), axis=1)
    return h


def sink_softmax_attend(q, k, v, allowed, sinks):
    s = jnp.einsum('...qkgd,...skd->...kgqs', q.astype(jnp.float32), k.astype(jnp.float32)) * (HEAD_DIM ** -0.5)
    s = jnp.where(allowed, s, -jnp.inf)
    sink = sinks.astype(jnp.float32)[..., None, None]
    m = jnp.maximum(jnp.max(s, axis=-1, keepdims=True), sink)
    p = jnp.exp(s - m)
    p = p / (jnp.sum(p, axis=-1, keepdims=True) + jnp.exp(sink - m))
    o = jnp.einsum('...kgqs,...skd->...qkgd', p, v.astype(jnp.float32))
    return o.astype(v.dtype)


def window_attention_prompt(q, k, v, sinks):
    bsz, s = q.shape[:2]
    nb = s // WINDOW
    qb = q.reshape(bsz, nb, WINDOW, N_KV_HEADS, KV_GROUP, HEAD_DIM)

    def band(t):
        tb = t.reshape(bsz, nb, WINDOW, N_KV_HEADS, HEAD_DIM)
        prev = jnp.concatenate([jnp.zeros_like(tb[:, :1]), tb[:, :-1]], axis=1)
        return jnp.concatenate([prev, tb], axis=2)

    qi = jnp.arange(WINDOW)[:, None]
    si = jnp.arange(2 * WINDOW)[None, :]
    blk = jnp.arange(nb)[:, None, None]
    diff = qi + WINDOW - si
    key_pos = blk * WINDOW - WINDOW + si
    allowed = ((diff >= 0) & (diff < WINDOW) & (key_pos >= 0))[:, None, None]
    o = sink_softmax_attend(qb, band(k), band(v), allowed, sinks.reshape(N_KV_HEADS, KV_GROUP))
    keep = min(WINDOW, s)
    return o.reshape(bsz, s, D_ATTN), k[:, s - keep:], v[:, s - keep:]


def window_attention_sample(q, k, v, sinks, k_buf, v_buf):
    n, t = q.shape[:2]
    w_buf = k_buf.shape[1]
    kk = jnp.concatenate([k_buf.astype(k.dtype), k], axis=1)
    vv = jnp.concatenate([v_buf.astype(v.dtype), v], axis=1)
    q_pos = PAST_LEN + jnp.arange(t)
    k_pos = PAST_LEN - w_buf + jnp.arange(w_buf + t)
    diff = q_pos[:, None] - k_pos[None, :]
    allowed = (diff >= 0) & (diff < WINDOW)
    qg = q.reshape(n, t, N_KV_HEADS, KV_GROUP, HEAD_DIM)
    o = sink_softmax_attend(qg, kk, vv, allowed, sinks.reshape(N_KV_HEADS, KV_GROUP))
    return o.reshape(n, t, D_ATTN), kk[:, t:], vv[:, t:]


def s5_mixer(u, h0_re, h0_im, lp):
    f32 = jnp.float32
    n, t = u.shape[:2]
    lam = lax.complex(lp['ssm_a_re'].astype(f32), lp['ssm_a_im'].astype(f32))
    dt = jnp.exp(lp['ssm_log_dt'].astype(f32))[:, None]
    a_bar = jnp.exp(lam * dt)
    b_mat = lax.complex(lp['ssm_b_re'].astype(f32), lp['ssm_b_im'].astype(f32))
    b_bar = ((a_bar - 1.0) / lam)[..., None] * b_mat
    uf = u.astype(f32)
    ug = uf.reshape(n, t, N_SSM_GROUPS, SSM_GROUP).astype(jnp.complex64)
    bu = jnp.einsum('ntgc,gpc->ntgp', ug, b_bar)
    h0 = lax.complex(h0_re.astype(f32), h0_im.astype(f32))
    h = linear_recurrence(jnp.broadcast_to(a_bar, bu.shape), bu, h0)
    c_mat = lax.complex(lp['ssm_c_re'].astype(f32), lp['ssm_c_im'].astype(f32))
    y = jnp.real(jnp.einsum('ntgp,gcp->ntgc', h, c_mat)).reshape(n, t, D_SSM)
    y = y + lp['ssm_d'].astype(f32) * uf
    g = jax.nn.gelu(y)
    out = g * jax.nn.sigmoid(g @ lp['ssm_w_glu'].astype(f32) + lp['ssm_b_glu'].astype(f32))
    h_last = h[:, -1]
    return out.astype(u.dtype), jnp.real(h_last), jnp.imag(h_last)


def rglru_mixer(xr, yg, conv_buf, h0, pos, lp):
    f32 = jnp.float32
    n, t = xr.shape[:2]
    xc, new_buf = causal_dwconv(xr, conv_buf, lp['lru_conv_w'], lp['lru_conv_b'])
    xf = xc.astype(f32)
    xh = xf.reshape(n, t, N_LRU_BLOCKS, LRU_BLOCK)
    r = jax.nn.sigmoid(jnp.einsum('nthi,hij->nthj', xh, lp['lru_w_a'].astype(f32)).reshape(n, t, D_LRU)
                       + lp['lru_b_a'].astype(f32))
    gi = jax.nn.sigmoid(jnp.einsum('nthi,hij->nthj', xh, lp['lru_w_i'].astype(f32)).reshape(n, t, D_LRU)
                        + lp['lru_b_i'].astype(f32))
    log_a = -LRU_C * r * jax.nn.softplus(-lp['lru_lambda'].astype(f32))
    a = jnp.exp(log_a)
    mult = jnp.sqrt(-jnp.expm1(2.0 * log_a))
    mult = jnp.where((pos == 0)[None, :, None], 1.0, mult)
    h = linear_recurrence(a, mult * gi * xf, h0.astype(f32))
    out = h * jax.nn.gelu(yg.astype(f32))
    return out.astype(xr.dtype), new_buf, h[:, -1]


def conv_ffn(h, buf, lp):
    up = h @ lp['ffn_w_up']
    upc, new_buf = causal_dwconv(up, buf, lp['ffn_conv_w'], lp['ffn_conv_b'])
    gate, val = upc[..., :D_FF], upc[..., D_FF:]
    return (jax.nn.gelu(gate) * val) @ lp['ffn_w_down'], new_buf


def trunk_layer(x, c, pos, lp, ssm_re, ssm_im, lru_h, lru_conv, ffn_conv, attend):
    n, t, _ = x.shape
    mod = jax.nn.silu(c) @ lp['w_ada'] + lp['b_ada']
    sh1, sc1, g1, sh2, sc2, g2 = [m[:, None, :] for m in jnp.split(mod, N_MOD, axis=-1)]
    h = rms_norm(x, lp['norm1']) * (1.0 + sc1) + sh1
    proj = h @ lp['w_in']
    c1 = D_ATTN
    c2 = c1 + D_KV
    c3 = c2 + D_KV
    c4 = c3 + D_SSM
    c5 = c4 + D_LRU
    q, k, v, u, xr, yg = jnp.split(proj, (c1, c2, c3, c4, c5), axis=-1)
    q = rotary(rms_norm(q.reshape(n, t, N_HEADS, HEAD_DIM), lp['q_norm']), pos)
    k = rotary(rms_norm(k.reshape(n, t, N_KV_HEADS, HEAD_DIM), lp['k_norm']), pos)
    v = v.reshape(n, t, N_KV_HEADS, HEAD_DIM)
    o_attn, k_new, v_new = attend(q, k, v, lp['sinks'])
    o_ssm, ssm_re_new, ssm_im_new = s5_mixer(u, ssm_re, ssm_im, lp)
    o_lru, lru_conv_new, lru_h_new = rglru_mixer(xr, yg, lru_conv, lru_h, pos, lp)
    on = lp['out_norm']
    o = jnp.concatenate([rms_norm(o_attn, on[:D_ATTN]),
                         rms_norm(o_ssm, on[D_ATTN:D_ATTN + D_SSM]),
                         rms_norm(o_lru, on[D_ATTN + D_SSM:])], axis=-1)
    x = x + g1 * (o @ lp['w_o'])
    h2 = rms_norm(x, lp['norm2']) * (1.0 + sc2) + sh2
    f, ffn_conv_new = conv_ffn(h2, ffn_conv, lp)
    x = x + g2 * f
    return x, (k_new, v_new, ssm_re_new, ssm_im_new, lru_h_new, lru_conv_new, ffn_conv_new)


def setup_inputs(seed: int = 0) -> dict:
    key = jax.random.key(seed)
    keys = iter(jax.random.split(key, 64))
    f32 = jnp.float32

    def nrm(shape, scale):
        return scale * jax.random.normal(next(keys), shape, f32)

    def gain(shape):
        return 1.0 + 0.02 * jax.random.normal(next(keys), shape, f32)

    L = DEPTH
    G, P = N_SSM_GROUPS, SSM_STATE
    w_buf = min(WINDOW, PAST_LEN)
    n_idx = jnp.arange(SSM_STATE, dtype=f32)
    a8 = jax.random.uniform(next(keys), (L, D_LRU), f32, 0.9, 0.999)
    a_base = a8 ** (1.0 / LRU_C)
    log_dt = jax.random.uniform(next(keys), (L, G), f32, math.log(1e-3), math.log(1e-1))
    return {
        'x_prompt': nrm((BATCH, SEQ, D_MODEL), 1.0),
        'x_sample': nrm((DEC_BATCH, DEC_SEQ, D_MODEL), 1.0),
        'cache_k': nrm((L, DEC_BATCH, w_buf, N_KV_HEADS, HEAD_DIM), 1.0),
        'cache_v': nrm((L, DEC_BATCH, w_buf, N_KV_HEADS, HEAD_DIM), 1.0),
        'state_ssm_re': nrm((L, DEC_BATCH, G, P), 0.1),
        'state_ssm_im': nrm((L, DEC_BATCH, G, P), 0.1),
        'state_lru_h': nrm((L, DEC_BATCH, D_LRU), 0.5),
        'state_lru_conv': nrm((L, DEC_BATCH, LRU_CONV - 1, D_LRU), 1.0),
        'state_ffn_conv': nrm((L, DEC_BATCH, FFN_CONV - 1, 2 * D_FF), 1.0),
        'c_prompt': nrm((BATCH, D_MODEL), 1.0),
        'c_sample': nrm((DEC_BATCH, D_MODEL), 1.0),
        'w_ada': nrm((L, D_MODEL, N_MOD * D_MODEL), 0.5 * D_MODEL ** -0.5),
        'b_ada': nrm((L, N_MOD * D_MODEL), 0.02),
        'norm1': gain((L, D_MODEL)),
        'w_in': nrm((L, D_MODEL, D_IN), D_MODEL ** -0.5),
        'q_norm': gain((L, HEAD_DIM)),
        'k_norm': gain((L, HEAD_DIM)),
        'sinks': nrm((L, N_HEADS), 0.5),
        'ssm_a_re': -0.5 + nrm((L, G, P), 0.01),
        'ssm_a_im': math.pi * n_idx + nrm((L, G, P), 0.01),
        'ssm_b_re': nrm((L, G, P, SSM_GROUP), (2 * SSM_GROUP) ** -0.5),
        'ssm_b_im': nrm((L, G, P, SSM_GROUP), (2 * SSM_GROUP) ** -0.5),
        'ssm_c_re': nrm((L, G, SSM_GROUP, P), 0.5),
        'ssm_c_im': nrm((L, G, SSM_GROUP, P), 0.5),
        'ssm_d': nrm((L, D_SSM), 1.0),
        'ssm_log_dt': log_dt,
        'ssm_w_glu': nrm((L, D_SSM, D_SSM), D_SSM ** -0.5),
        'ssm_b_glu': nrm((L, D_SSM), 0.02),
        'lru_conv_w': nrm((L, LRU_CONV, D_LRU), LRU_CONV ** -0.5),
        'lru_conv_b': nrm((L, D_LRU), 0.02),
        'lru_w_a': nrm((L, N_LRU_BLOCKS, LRU_BLOCK, LRU_BLOCK), LRU_BLOCK ** -0.5),
        'lru_b_a': nrm((L, D_LRU), 0.02),
        'lru_w_i': nrm((L, N_LRU_BLOCKS, LRU_BLOCK, LRU_BLOCK), LRU_BLOCK ** -0.5),
        'lru_b_i': nrm((L, D_LRU), 0.02),
        'lru_lambda': jnp.log(a_base) - jnp.log1p(-a_base),
        'out_norm': gain((L, D_MIX)),
        'w_o': nrm((L, D_MIX, D_MODEL), D_MIX ** -0.5),
        'norm2': gain((L, D_MODEL)),
        'ffn_w_up': nrm((L, D_MODEL, 2 * D_FF), D_MODEL ** -0.5),
        'ffn_conv_w': nrm((L, FFN_CONV, 2 * D_FF), FFN_CONV ** -0.5),
        'ffn_conv_b': nrm((L, 2 * D_FF), 0.02),
        'ffn_w_down': nrm((L, D_FF, D_MODEL), D_FF ** -0.5),
    }


def reference(x_prompt, x_sample, cache_k, cache_v, state_ssm_re, state_ssm_im, state_lru_h,
              state_lru_conv, state_ffn_conv, c_prompt, c_sample, w_ada, b_ada, norm1, w_in,
              q_norm, k_norm, sinks, ssm_a_re, ssm_a_im, ssm_b_re, ssm_b_im, ssm_c_re, ssm_c_im,
              ssm_d, ssm_log_dt, ssm_w_glu, ssm_b_glu, lru_conv_w, lru_conv_b, lru_w_a, lru_b_a,
              lru_w_i, lru_b_i, lru_lambda, out_norm, w_o, norm2, ffn_w_up, ffn_conv_w,
              ffn_conv_b, ffn_w_down):
    params = dict(w_ada=w_ada, b_ada=b_ada, norm1=norm1, w_in=w_in, q_norm=q_norm, k_norm=k_norm,
                  sinks=sinks, ssm_a_re=ssm_a_re, ssm_a_im=ssm_a_im, ssm_b_re=ssm_b_re,
                  ssm_b_im=ssm_b_im, ssm_c_re=ssm_c_re, ssm_c_im=ssm_c_im, ssm_d=ssm_d,
                  ssm_log_dt=ssm_log_dt, ssm_w_glu=ssm_w_glu, ssm_b_glu=ssm_b_glu,
                  lru_conv_w=lru_conv_w, lru_conv_b=lru_conv_b, lru_w_a=lru_w_a, lru_b_a=lru_b_a,
                  lru_w_i=lru_w_i, lru_b_i=lru_b_i, lru_lambda=lru_lambda, out_norm=out_norm,
                  w_o=w_o, norm2=norm2, ffn_w_up=ffn_w_up, ffn_conv_w=ffn_conv_w,
                  ffn_conv_b=ffn_conv_b, ffn_w_down=ffn_w_down)
    f32 = jnp.float32
    bsz, seq = x_prompt.shape[:2]
    dseq = x_sample.shape[1]
    pos_prompt = jnp.arange(seq, dtype=f32)
    pos_sample = PAST_LEN + jnp.arange(dseq, dtype=f32)
    xp, xs = x_prompt, x_sample
    new_p, new_s = [], []
    for i in range(DEPTH):
        lp = {name: arr[i] for name, arr in params.items()}
        xp, st_p = trunk_layer(
            xp, c_prompt, pos_prompt, lp,
            jnp.zeros((bsz, N_SSM_GROUPS, SSM_STATE), f32),
            jnp.zeros((bsz, N_SSM_GROUPS, SSM_STATE), f32),
            jnp.zeros((bsz, D_LRU), f32),
            jnp.zeros((bsz, LRU_CONV - 1, D_LRU), xp.dtype),
            jnp.zeros((bsz, FFN_CONV - 1, 2 * D_FF), xp.dtype),
            window_attention_prompt)
        xs, st_s = trunk_layer(
            xs, c_sample, pos_sample, lp,
            state_ssm_re[i], state_ssm_im[i], state_lru_h[i], state_lru_conv[i], state_ffn_conv[i],
            functools.partial(window_attention_sample, k_buf=cache_k[i], v_buf=cache_v[i]))
        new_p.append(st_p)
        new_s.append(st_s)
    pk, pv, p_re, p_im, p_lh, p_lc, p_fc = [jnp.stack(s) for s in zip(*new_p)]
    sk, sv, s_re, s_im, s_lh, s_lc, s_fc = [jnp.stack(s) for s in zip(*new_s)]
    return (xp, xs, pk, pv, p_re, p_im, p_lh, p_lc, p_fc, sk, sv, s_re, s_im, s_lh, s_lc, s_fc)
```

```cpp
#include <hip/hip_runtime.h>
#include <hip/hip_cooperative_groups.h>
#include <cstdio>
namespace cg = cooperative_groups;

typedef unsigned short bf16_t;
typedef short bf16x8 __attribute__((ext_vector_type(8)));
typedef float f32x4 __attribute__((ext_vector_type(4)));
typedef unsigned u32x4 __attribute__((ext_vector_type(4)));
typedef unsigned u32x2 __attribute__((ext_vector_type(2)));
#define LAS __attribute__((address_space(3)))
#define DI __device__ __forceinline__

constexpr int DM = 1024, NP = 16384, NS = 512, NTOK = NP + NS, NSEQ = 132, DEPTH = 4;
constexpr int DIN = 1536, DFF = 2816, DUP = 5632, NMOD = 6144, NMODALL = 4 * NMOD;
constexpr float EPS = 1e-6f;

enum { I_XP = 0, I_XS, I_CK, I_CV, I_SRE, I_SIM, I_SLH, I_SLC, I_SFC, I_CP, I_CS, I_WADA, I_BADA, I_NORM1, I_WIN, I_QN, I_KN, I_SINK,
       I_ARE, I_AIM, I_BRE, I_BIM, I_CRE, I_CIM, I_SD, I_LDT, I_WGLU, I_BGLU, I_LCW, I_LCB, I_LWA, I_LBA, I_LWI, I_LBI, I_LAM, I_ON,
       I_WO, I_NORM2, I_WUP, I_FCW, I_FCB, I_WDN, N_IN };

constexpr size_t O_YP = 0;
constexpr size_t O_YS = O_YP + (size_t)NP * DM;
constexpr size_t O_PK = O_YS + (size_t)NS * DM;
constexpr size_t O_PV = O_PK + (size_t)4 * 4 * 128 * 128;
constexpr size_t O_PRE = O_PV + (size_t)4 * 4 * 128 * 128;
constexpr size_t O_PIM = O_PRE + (size_t)4 * 4 * 1024;
constexpr size_t O_PLH = O_PIM + (size_t)4 * 4 * 1024;
constexpr size_t O_PLC = O_PLH + (size_t)4 * 4 * 256;
constexpr size_t O_PFC = O_PLC + (size_t)4 * 4 * 3 * 256;
constexpr size_t O_SK = O_PFC + (size_t)4 * 4 * 2 * DUP;
constexpr size_t O_SV = O_SK + (size_t)4 * 128 * 128 * 128;
constexpr size_t O_SRE = O_SV + (size_t)4 * 128 * 128 * 128;
constexpr size_t O_SIM = O_SRE + (size_t)4 * 128 * 1024;
constexpr size_t O_SLH = O_SIM + (size_t)4 * 128 * 1024;
constexpr size_t O_SLC = O_SLH + (size_t)4 * 128 * 256;
constexpr size_t O_SFC = O_SLC + (size_t)4 * 128 * 3 * 256;
constexpr size_t O_END = O_SFC + (size_t)4 * 128 * 2 * DUP;

constexpr size_t al256(size_t x) { return (x + 255) & ~(size_t)255; }
constexpr size_t W_WTIN = 0;
constexpr size_t W_WTO = al256(W_WTIN + (size_t)4 * DIN * DM * 2);
constexpr size_t W_WTUP = al256(W_WTO + (size_t)4 * DM * DM * 2);
constexpr size_t W_WTDN = al256(W_WTUP + (size_t)4 * DUP * DM * 2);
constexpr size_t W_MOD = al256(W_WTDN + (size_t)4 * DM * DFF * 2);
constexpr size_t W_ROTC = al256(W_MOD + (size_t)NSEQ * NMODALL * 4);
constexpr size_t W_ROTS = al256(W_ROTC + (size_t)4100 * 32 * 4);
constexpr size_t W_ABAR = al256(W_ROTS + (size_t)4100 * 32 * 4);
constexpr size_t W_BB = al256(W_ABAR + (size_t)4 * 16 * 64 * 2 * 4);
constexpr size_t W_SST = al256(W_BB + (size_t)4 * 16 * 2 * 64 * 16 * 4);
constexpr size_t W_LAG = al256(W_SST + (size_t)4 * 64 * 16 * 64 * 2 * 4);
constexpr size_t W_H2 = al256(W_LAG + (size_t)4 * 64 * 2 * 256 * 4);
constexpr size_t W_R1 = al256(W_H2 + (size_t)NTOK * DM * 2);
constexpr size_t W_UP = W_R1;
constexpr size_t W_H = W_R1;
constexpr size_t W_Q = al256(W_H + (size_t)NTOK * DM * 2);
constexpr size_t W_KB = al256(W_Q + (size_t)NTOK * 512 * 2);
constexpr size_t W_VB = al256(W_KB + (size_t)NTOK * 128 * 2);
constexpr size_t W_U = al256(W_VB + (size_t)NTOK * 128 * 2);
constexpr size_t W_XR = al256(W_U + (size_t)NTOK * 256 * 4);
constexpr size_t W_YG = al256(W_XR + (size_t)NTOK * 256 * 4);
constexpr size_t W_OATT = al256(W_YG + (size_t)NTOK * 256 * 4);
constexpr size_t W_O = al256(W_OATT + (size_t)NTOK * 512 * 4);
constexpr size_t W_R1END = al256(W_O + (size_t)NTOK * DM * 2);
constexpr size_t W_R2 = al256(W_R1 + (size_t)NTOK * DUP * 2);
constexpr size_t W_ACT = W_R2;
constexpr size_t W_WTADA = W_R2;
constexpr size_t W_CSILU = al256(W_WTADA + (size_t)NMODALL * DM * 2);
constexpr size_t W_R2A = al256(W_CSILU + (size_t)256 * DM * 2);
constexpr size_t W_R2B = al256(W_R2 + (size_t)NTOK * DFF * 2);
constexpr size_t W_END = (W_R2A > W_R2B ? W_R2A : W_R2B);
static_assert(W_R1END <= W_R2, "mixer buffers must fit in the UP region");

constexpr int LDS_BYTES = 131072;
#ifndef ONLY_PH
#define ONLY_PH -1
#endif
#define EN(k) (ONLY_PH < 0 || ONLY_PH == (k))
#ifndef MAX_ORD
#define MAX_ORD 1000
#define MULTI_LAUNCH 0
#define SIMPLE_GEMM 0
#define EVICT_KB 352
#endif
#define ORD(o) ((o) >= P.ph_lo && (o) < P.ph_hi && ((o) <= (MAX_ORD) || (o) >= 38))

struct Params {
    const float* in[N_IN];
    float* out;
    unsigned char* ws;
    int ph_lo, ph_hi;
};

struct PV {
    const Params& P; int z; float* out; unsigned char* ws; int tid, bid, nb;
    __device__ __forceinline__ const float* in_(int i) const { return P.in[i + z]; }
};

DI unsigned cvt_pk_bf16(float lo, float hi) { unsigned r; asm volatile("v_cvt_pk_bf16_f32 %0, %1, %2" : "=v"(r) : "v"(lo), "v"(hi)); return r; }
DI bf16_t f2bf(float f) { return (bf16_t)(cvt_pk_bf16(f, 0.f) & 0xffffu); }
DI float bf2f(bf16_t b) { return __uint_as_float(((unsigned)b) << 16); }
DI float gelu_t(float x) { const float u = 1.5957691216f * (x + 0.044715f * x * x * x); return x / (1.f + __expf(-u)); }
DI float sigm(float x) { return 1.f / (1.f + __expf(-x)); }
DI int seq_of(int row) { return row < NP ? (row >> 12) : 4 + ((row - NP) >> 2); }
DI bf16x8 pack8(f32x4 a, f32x4 b) {
    u32x4 r; r.x = cvt_pk_bf16(a.x, a.y); r.y = cvt_pk_bf16(a.z, a.w); r.z = cvt_pk_bf16(b.x, b.y); r.w = cvt_pk_bf16(b.z, b.w);
    return __builtin_bit_cast(bf16x8, r);
}
DI float wave_sum(float v) {
#pragma unroll
    for (int o = 1; o < 64; o <<= 1) v += __shfl_xor(v, o);
    return v;
}
DI float sum16(float v) {
#pragma unroll
    for (int o = 1; o < 16; o <<= 1) v += __shfl_xor(v, o);
    return v;
}
DI float max16(float v) {
#pragma unroll
    for (int o = 1; o < 16; o <<= 1) v = fmaxf(v, __shfl_xor(v, o));
    return v;
}
#define MFMA16(a, b, c) __builtin_amdgcn_mfma_f32_16x16x32_bf16((a), (b), (c), 0, 0, 0)

#ifndef GLDS_AUX
#define GLDS_AUX 0
#endif
namespace pg8 {
constexpr int BM = 256, BK = 64, HALF = 128, HTB = HALF * BK * 2, STAGE_BYTES = 8 * HTB, NXCD = 8, WGM = 8;
DI int lds_byte(int r, int c) { const int st = (r >> 4) * 2 + (c >> 5), rr = r & 15, cc = c & 31, ob = rr * 64 + cc * 2; return st * 1024 + (ob ^ (((ob >> 9) & 1) << 5)); }
DI void stage_rc(int b, int& R, int& C) { const int st = b / 1024, sb = b % 1024, swz = sb ^ (((sb >> 9) & 1) << 5); R = (st >> 1) * 16 + swz / 64; C = (st & 1) * 32 + (swz % 64) / 2; }
struct Unit { int pm, pn; };
struct Gemm { const bf16_t* A; const bf16_t* Bt; int M, N, K; };
struct StaticOrder {
    int nM, nN, nwg, G, c;
    DI void init(int M, int N, int G_, int c_) { nM = M / BM; nN = N / BM; nwg = nM * nN; G = G_; c = c_; }
    DI bool next(int i, Unit& u) const {
        const long L = (long)i * G + c; if (L >= nwg) return false;
        int wgid = (int)L; { const int q = nwg / NXCD, r = nwg % NXCD, xcd = wgid % NXCD, off = wgid / NXCD; wgid = (xcd < r ? xcd * (q + 1) : r * (q + 1) + (xcd - r) * q) + off; }
        const int nig = WGM * nN, gid = wgid / nig, fm = gid * WGM, gsz = (nM - fm) < WGM ? (nM - fm) : WGM;
        u.pm = fm + ((wgid % nig) % gsz); u.pn = (wgid % nig) / gsz; return true;
    }
};
template <class Epi>
DI void gemm_phase(const PV& p, LAS unsigned char* lds, const Gemm g, const StaticOrder& S, const Epi& E) {
    const int tid = p.tid, wid = __builtin_amdgcn_readfirstlane(tid >> 6), lane = tid & 63, wr = wid >> 2, wc = wid & 3, fr = lane & 15, fq = lane >> 4;
    const int K = g.K, nt = K / BK;
    unsigned voffA[2];
#pragma unroll
    for (int i = 0; i < 2; ++i) { int R, C; stage_rc(tid * 16 + i * 8192, R, C); voffA[i] = (unsigned)(R * K + C) * 2u; }
    const size_t kstep = (size_t)(BK * 2);
    const size_t hstep = (size_t)HALF * K * 2;
    const size_t tstep = 2 * hstep;
    const unsigned ldsw = (unsigned)wid * 1024u;
    const int aoff = lds_byte(wr * 64 + fr, fq * 8), boff = lds_byte(wc * 32 + fr, fq * 8);
#define PG8_SA(b, h) (((b) * 2 + (h)) * HTB)
#define PG8_SB(b, h) ((4 + (b) * 2 + (h)) * HTB)
#define PG8_STAGE(bufoff, gbase) do { _Pragma("unroll") for (int _i = 0; _i < 2; ++_i) \
        __builtin_amdgcn_global_load_lds((const unsigned*)((const char*)(gbase) + voffA[_i]), (LAS unsigned*)(lds + (bufoff) + ldsw + _i * 8192), 16, 0, GLDS_AUX); } while (0)
#define PG8_LDA(dst, b, h) do { _Pragma("unroll") for (int m = 0; m < 4; ++m) _Pragma("unroll") for (int k = 0; k < 2; ++k) dst[m][k] = *(const LAS bf16x8*)(lds + PG8_SA(b, h) + aoff + m * 2048 + k * 1024); } while (0)
#define PG8_LDB(dst, b, h) do { _Pragma("unroll") for (int n = 0; n < 2; ++n) _Pragma("unroll") for (int k = 0; k < 2; ++k) dst[n][k] = *(const LAS bf16x8*)(lds + PG8_SB(b, h) + boff + n * 2048 + k * 1024); } while (0)
#define PG8_MMA(ai, bj, At, Bt) do { __builtin_amdgcn_s_setprio(1); _Pragma("unroll") for (int m = 0; m < 4; ++m) _Pragma("unroll") for (int n = 0; n < 2; ++n) _Pragma("unroll") for (int k = 0; k < 2; ++k) \
        acc[ai][bj][m][n] = __builtin_amdgcn_mfma_f32_16x16x32_bf16(Bt[n][k], At[m][k], acc[ai][bj][m][n], 0, 0, 0); __builtin_amdgcn_s_setprio(0); } while (0)
#define PG8_WAIT_V(n) asm volatile("s_waitcnt vmcnt(" #n ")" ::: "memory")
#define PG8_WAIT_L(n) asm volatile("s_waitcnt lgkmcnt(" #n ")" ::: "memory")
#define PG8_BAR __builtin_amdgcn_s_barrier()
#define PG8_SCHED __builtin_amdgcn_sched_barrier(0)
    Unit cur, nxt; int ui = 0;
    if (!S.next(0, cur)) return;
    f32x4 acc[2][2][4][2];
#pragma unroll
    for (int a = 0; a < 2; ++a)
#pragma unroll
        for (int b = 0; b < 2; ++b)
#pragma unroll
            for (int m = 0; m < 4; ++m)
#pragma unroll
                for (int n = 0; n < 2; ++n) acc[a][b][m][n] = (f32x4){0.f, 0.f, 0.f, 0.f};
    bf16x8 At[4][2], B0[2][2], B1[2][2];
    const char* cA = (const char*)g.A + (size_t)cur.pm * tstep; const char* cB = (const char*)g.Bt + (size_t)cur.pn * tstep;
    PG8_STAGE(PG8_SB(0, 0), cB); PG8_STAGE(PG8_SA(0, 0), cA); PG8_STAGE(PG8_SB(0, 1), cB + hstep); PG8_STAGE(PG8_SA(0, 1), cA + hstep);
    if (wr == 1) PG8_BAR;
    PG8_WAIT_V(4); PG8_BAR;
    PG8_STAGE(PG8_SB(1, 0), cB + kstep); PG8_STAGE(PG8_SA(1, 0), cA + kstep); PG8_STAGE(PG8_SB(1, 1), cB + hstep + kstep);
    PG8_WAIT_V(6); PG8_BAR;
    for (;;) {
        const bool has_next = S.next(ui + 1, nxt);
        const char* nA = has_next ? (const char*)g.A + (size_t)nxt.pm * tstep : cA; const char* nB = has_next ? (const char*)g.Bt + (size_t)nxt.pn * tstep : cB;
        for (int t = 0; t < nt; t += 2) {
            const bool last = (t == nt - 2);
            const char* a1 = cA + (size_t)(t + 1) * kstep;
            const char* a2 = last ? nA : cA + (size_t)(t + 2) * kstep; const char* b2 = last ? nB : cB + (size_t)(t + 2) * kstep;
            const char* a3 = a2 + kstep; const char* b3 = b2 + kstep;
            PG8_LDB(B0, 0, 0); PG8_SCHED; PG8_LDA(At, 0, 0); PG8_STAGE(PG8_SA(1, 1), a1 + hstep);
            PG8_WAIT_L(8); PG8_BAR; PG8_WAIT_L(0); PG8_MMA(0, 0, At, B0); PG8_BAR; PG8_SCHED;
            PG8_LDB(B1, 0, 1); PG8_STAGE(PG8_SB(0, 0), b2);
            PG8_BAR; PG8_WAIT_L(0); PG8_MMA(0, 1, At, B1); PG8_BAR;
            PG8_LDA(At, 0, 1); PG8_STAGE(PG8_SA(0, 0), a2);
            PG8_BAR; PG8_WAIT_L(0); PG8_MMA(1, 0, At, B0); PG8_BAR; PG8_SCHED;
            PG8_STAGE(PG8_SB(0, 1), b2 + hstep);
            PG8_WAIT_V(6); PG8_BAR; PG8_MMA(1, 1, At, B1); PG8_BAR;
            PG8_LDB(B0, 1, 0); PG8_SCHED; PG8_LDA(At, 1, 0); PG8_STAGE(PG8_SA(0, 1), a2 + hstep);
            PG8_WAIT_L(8); PG8_BAR; PG8_WAIT_L(0); PG8_MMA(0, 0, At, B0); PG8_BAR; PG8_SCHED;
            PG8_LDB(B1, 1, 1); PG8_STAGE(PG8_SB(1, 0), b3);
            PG8_BAR; PG8_WAIT_L(0); PG8_MMA(0, 1, At, B1); PG8_BAR;
            PG8_LDA(At, 1, 1); PG8_STAGE(PG8_SA(1, 0), a3);
            PG8_BAR; PG8_WAIT_L(0); PG8_MMA(1, 0, At, B0); PG8_BAR; PG8_SCHED;
            PG8_STAGE(PG8_SB(1, 1), b3 + hstep);
            PG8_WAIT_V(6); PG8_BAR; PG8_MMA(1, 1, At, B1); PG8_BAR;
        }
        E(acc, cur, wr, wc, fr, fq);
        asm volatile("s_waitcnt vmcnt(0)" ::: "memory");
        if (!has_next) break;
#pragma unroll
        for (int a = 0; a < 2; ++a)
#pragma unroll
            for (int b = 0; b < 2; ++b)
#pragma unroll
                for (int m = 0; m < 4; ++m)
#pragma unroll
                    for (int n = 0; n < 2; ++n) acc[a][b][m][n] = (f32x4){0.f, 0.f, 0.f, 0.f};
        cur = nxt; cA = nA; cB = nB; ++ui;
    }
    PG8_WAIT_V(0);
    if (wr == 0) PG8_BAR;
    PG8_BAR;
#undef PG8_SA
#undef PG8_SB
#undef PG8_STAGE
#undef PG8_LDA
#undef PG8_LDB
#undef PG8_MMA
#undef PG8_WAIT_V
#undef PG8_WAIT_L
#undef PG8_BAR
#undef PG8_SCHED
}

template <class Epi>
DI void gemm_simple(const PV& p, LAS unsigned char* lds, const Gemm g, const StaticOrder& S, const Epi& E) {
    const int tid = p.tid, wid = __builtin_amdgcn_readfirstlane(tid >> 6), lane = tid & 63, wr = wid >> 2, wc = wid & 3, fr = lane & 15, fq = lane >> 4;
    const int K = g.K, nk = K / 32;
    constexpr int RS = 80;
    constexpr int TB = 256 * RS;
    const int srow = tid >> 1, shalf = tid & 1;
    Unit cur;
    for (int ui = 0; S.next(ui, cur); ++ui) {
        f32x4 acc[2][2][4][2];
#pragma unroll
        for (int a = 0; a < 2; ++a)
#pragma unroll
            for (int b = 0; b < 2; ++b)
#pragma unroll
                for (int m = 0; m < 4; ++m)
#pragma unroll
                    for (int n = 0; n < 2; ++n) acc[a][b][m][n] = (f32x4){0.f, 0.f, 0.f, 0.f};
        const bf16_t* ga = g.A + (size_t)(cur.pm * 256 + srow) * K + shalf * 16;
        const bf16_t* gb = g.Bt + (size_t)(cur.pn * 256 + srow) * K + shalf * 16;
        u32x4 ra0 = *(const u32x4*)ga, ra1 = *(const u32x4*)(ga + 8), rb0 = *(const u32x4*)gb, rb1 = *(const u32x4*)(gb + 8);
        __syncthreads();
        {
            LAS unsigned char* wa = lds + srow * RS + shalf * 32; LAS unsigned char* wb = wa + TB;
            *(LAS u32x4*)wa = ra0; *(LAS u32x4*)(wa + 16) = ra1; *(LAS u32x4*)wb = rb0; *(LAS u32x4*)(wb + 16) = rb1;
        }
        __syncthreads();
#pragma unroll 1
        for (int t = 0; t < nk; ++t) {
            const int cb = (t & 1) * 2 * TB, nb = ((t + 1) & 1) * 2 * TB;
            if (t + 1 < nk) { ra0 = *(const u32x4*)(ga + (t + 1) * 32); ra1 = *(const u32x4*)(ga + (t + 1) * 32 + 8); rb0 = *(const u32x4*)(gb + (t + 1) * 32); rb1 = *(const u32x4*)(gb + (t + 1) * 32 + 8); }
            bf16x8 Bf[2][2];
#pragma unroll
            for (int bj = 0; bj < 2; ++bj)
#pragma unroll
                for (int n = 0; n < 2; ++n) Bf[bj][n] = *(const LAS bf16x8*)(lds + cb + TB + (bj * 128 + wc * 32 + n * 16 + fr) * RS + fq * 16);
#pragma unroll
            for (int ai = 0; ai < 2; ++ai)
#pragma unroll
                for (int m = 0; m < 4; ++m) {
                    const bf16x8 Af = *(const LAS bf16x8*)(lds + cb + (ai * 128 + wr * 64 + m * 16 + fr) * RS + fq * 16);
#pragma unroll
                    for (int bj = 0; bj < 2; ++bj)
#pragma unroll
                        for (int n = 0; n < 2; ++n) acc[ai][bj][m][n] = __builtin_amdgcn_mfma_f32_16x16x32_bf16(Bf[bj][n], Af, acc[ai][bj][m][n], 0, 0, 0);
                }
            if (t + 1 < nk) {
                LAS unsigned char* wa = lds + nb + srow * RS + shalf * 32; LAS unsigned char* wb = wa + TB;
                *(LAS u32x4*)wa = ra0; *(LAS u32x4*)(wa + 16) = ra1; *(LAS u32x4*)wb = rb0; *(LAS u32x4*)(wb + 16) = rb1;
            }
            __syncthreads();
        }
        E(acc, cur, wr, wc, fr, fq);
    }
    __syncthreads();
}
}
using pg8::Unit;
typedef f32x4 AccT[2][2][4][2];

struct EpiAda {
    float* MOD; const float* bias;
    DI void operator()(const AccT& acc, const Unit& u, int wr, int wc, int fr, int fq) const {
#pragma unroll
        for (int ai = 0; ai < 2; ++ai)
#pragma unroll
            for (int m = 0; m < 4; ++m) {
                const int r = u.pm * 256 + ai * 128 + wr * 64 + m * 16 + fr;
                if (r < NSEQ) {
#pragma unroll
                    for (int bj = 0; bj < 2; ++bj)
#pragma unroll
                        for (int n = 0; n < 2; ++n) {
                            const int col = u.pn * 256 + bj * 128 + wc * 32 + n * 16 + 4 * fq;
                            *(f32x4*)(MOD + (size_t)r * NMODALL + col) = acc[ai][bj][m][n] + *(const f32x4*)(bias + col);
                        }
                }
            }
    }
};

struct EpiIn {
    int layer;
    bf16_t* Q; bf16_t* Kb; bf16_t* Vb; float* U; float* XR; float* YG;
    const float* qn; const float* kn; const float* rotc; const float* rots; float* out;
    DI void operator()(const AccT& acc, const Unit& u, int wr, int wc, int fr, int fq) const {
        const int pn = u.pn;
#pragma unroll
        for (int ai = 0; ai < 2; ++ai)
#pragma unroll
            for (int m = 0; m < 4; ++m) {
                const int row = u.pm * 256 + ai * 128 + wr * 64 + m * 16 + fr;
                const bool prm = row < NP;
                const int b = row >> 12, pos = row & 4095, sq = (row - NP) >> 2, tt = row & 3;
                if (pn <= 1 || (pn == 2 && wc < 2)) {
                    float ss = 0.f;
#pragma unroll
                    for (int bj = 0; bj < 2; ++bj)
#pragma unroll
                        for (int n = 0; n < 2; ++n) { const f32x4 v = acc[ai][bj][m][n]; ss += v.x * v.x + v.y * v.y + v.z * v.z + v.w * v.w; }
                    ss += __shfl_xor(ss, 16); ss += __shfl_xor(ss, 32);
                    const float rinv = rsqrtf(ss * (1.f / 64.f) + EPS);
                    const float* w = (pn <= 1 ? qn : kn) + layer * 64;
                    const int pi = prm ? pos : 4096 + tt;
#pragma unroll
                    for (int n = 0; n < 2; ++n) {
                        const int i = 16 * n + 4 * fq;
                        const f32x4 c4 = *(const f32x4*)(rotc + pi * 32 + i), s4 = *(const f32x4*)(rots + pi * 32 + i);
                        const f32x4 w1 = *(const f32x4*)(w + i), w2 = *(const f32x4*)(w + 32 + i);
                        const f32x4 x1 = acc[ai][0][m][n] * rinv * w1, x2 = acc[ai][1][m][n] * rinv * w2;
                        f32x4 o1 = x1 * c4 - x2 * s4, o2 = x2 * c4 + x1 * s4;
                        if (pn <= 1) {
                            const int head = pn * 4 + wc;
                            o1 = o1 * 0.125f; o2 = o2 * 0.125f;
                            bf16_t* qp = Q + (size_t)row * 512 + head * 64 + i;
                            u32x2 a; a.x = cvt_pk_bf16(o1.x, o1.y); a.y = cvt_pk_bf16(o1.z, o1.w); *(u32x2*)qp = a;
                            u32x2 c; c.x = cvt_pk_bf16(o2.x, o2.y); c.y = cvt_pk_bf16(o2.z, o2.w); *(u32x2*)(qp + 32) = c;
                        } else {
                            const int kvh = wc;
                            bf16_t* kp = Kb + (size_t)row * 128 + kvh * 64 + i;
                            u32x2 a; a.x = cvt_pk_bf16(o1.x, o1.y); a.y = cvt_pk_bf16(o1.z, o1.w); *(u32x2*)kp = a;
                            u32x2 c; c.x = cvt_pk_bf16(o2.x, o2.y); c.y = cvt_pk_bf16(o2.z, o2.w); *(u32x2*)(kp + 32) = c;
                            float* co = nullptr;
                            if (prm) { if (pos >= 3968) co = out + O_PK + ((size_t)(layer * 4 + b) * 128 + (pos - 3968)) * 128; }
                            else co = out + O_SK + ((size_t)(layer * 128 + sq) * 128 + 124 + tt) * 128;
                            if (co) { *(f32x4*)(co + kvh * 64 + i) = o1; *(f32x4*)(co + kvh * 64 + 32 + i) = o2; }
                        }
                    }
                } else if (pn == 2) {
                    const int kvh = wc - 2;
                    float* co = nullptr;
                    if (prm) { if (pos >= 3968) co = out + O_PV + ((size_t)(layer * 4 + b) * 128 + (pos - 3968)) * 128; }
                    else co = out + O_SV + ((size_t)(layer * 128 + sq) * 128 + 124 + tt) * 128;
#pragma unroll
                    for (int bj = 0; bj < 2; ++bj)
#pragma unroll
                        for (int n = 0; n < 2; ++n) {
                            const int d = 32 * bj + 16 * n + 4 * fq; const f32x4 v = acc[ai][bj][m][n];
                            u32x2 a; a.x = cvt_pk_bf16(v.x, v.y); a.y = cvt_pk_bf16(v.z, v.w);
                            *(u32x2*)(Vb + (size_t)row * 128 + kvh * 64 + d) = a;
                            if (co) *(f32x4*)(co + kvh * 64 + d) = v;
                        }
                } else {
                    float* dst = (pn == 3 ? U : (pn == 4 ? XR : YG)) + (size_t)row * 256;
                    float* co = nullptr;
                    if (pn == 4) {
                        if (prm) { if (pos >= 4093) co = out + O_PLC + ((size_t)(layer * 4 + b) * 3 + (pos - 4093)) * 256; }
                        else if (tt >= 1) co = out + O_SLC + ((size_t)(layer * 128 + sq) * 3 + (tt - 1)) * 256;
                    }
#pragma unroll
                    for (int bj = 0; bj < 2; ++bj)
#pragma unroll
                        for (int n = 0; n < 2; ++n) {
                            const int c = 64 * wc + 32 * bj + 16 * n + 4 * fq;
                            *(f32x4*)(dst + c) = acc[ai][bj][m][n];
                            if (co) *(f32x4*)(co + c) = acc[ai][bj][m][n];
                        }
                }
            }
    }
};

struct EpiRes {
    const float* xp; const float* xs_adj; float* X; const float* MODg;
    DI void operator()(const AccT& acc, const Unit& u, int wr, int wc, int fr, int fq) const {
#pragma unroll
        for (int ai = 0; ai < 2; ++ai)
#pragma unroll
            for (int m = 0; m < 4; ++m) {
                const int row = u.pm * 256 + ai * 128 + wr * 64 + m * 16 + fr;
                const float* g = MODg + (size_t)seq_of(row) * NMODALL;
                const float* xs = (row < NP ? xp : xs_adj) + (size_t)row * DM;
                float* xo = X + (size_t)row * DM;
#pragma unroll
                for (int bj = 0; bj < 2; ++bj)
#pragma unroll
                    for (int n = 0; n < 2; ++n) {
                        const int col = u.pn * 256 + bj * 128 + wc * 32 + n * 16 + 4 * fq;
                        *(f32x4*)(xo + col) = *(const f32x4*)(xs + col) + *(const f32x4*)(g + col) * acc[ai][bj][m][n];
                    }
            }
    }
};

struct EpiUp {
    int layer; bf16_t* UP; float* out;
    DI void operator()(const AccT& acc, const Unit& u, int wr, int wc, int fr, int fq) const {
#pragma unroll
        for (int ai = 0; ai < 2; ++ai)
#pragma unroll
            for (int m = 0; m < 4; ++m) {
                const int row = u.pm * 256 + ai * 128 + wr * 64 + m * 16 + fr;
                const int b = row >> 12, pos = row & 4095, sq = (row - NP) >> 2, tt = row & 3;
                float* co = nullptr;
                if (row < NP) { if (pos >= 4094) co = out + O_PFC + ((size_t)(layer * 4 + b) * 2 + (pos - 4094)) * DUP; }
                else if (tt >= 2) co = out + O_SFC + ((size_t)(layer * 128 + sq) * 2 + (tt - 2)) * DUP;
#pragma unroll
                for (int bj = 0; bj < 2; ++bj)
#pragma unroll
                    for (int n = 0; n < 2; ++n) {
                        const int col = u.pn * 256 + bj * 128 + wc * 32 + n * 16 + 4 * fq; const f32x4 v = acc[ai][bj][m][n];
                        u32x2 a; a.x = cvt_pk_bf16(v.x, v.y); a.y = cvt_pk_bf16(v.z, v.w);
                        *(u32x2*)(UP + (size_t)row * DUP + col) = a;
                        if (co) *(f32x4*)(co + col) = v;
                    }
            }
    }
};

template <class Epi>
DI void run_gemm(const PV& p, LAS unsigned char* lds, const bf16_t* A, const bf16_t* Bt, int M, int N, int K, const Epi& E) {
    pg8::Gemm g; g.A = A; g.Bt = Bt; g.M = M; g.N = N; g.K = K;
    pg8::StaticOrder S; S.init(M, N, (int)p.nb, (int)p.bid);
#if SIMPLE_GEMM
    pg8::gemm_simple<Epi>(p, lds, g, S, E);
#else
    pg8::gemm_phase<Epi>(p, lds, g, S, E);
#endif
}

DI void tr_tile(const PV& p, const float* W, int K, int N, bf16_t* Wt, int tile, bool perm, LAS float* t) {
    const int ntn = N >> 6, kb = tile / ntn, nb = tile - kb * ntn, k0 = kb * 64, n0 = nb * 64, tid = p.tid;
#pragma unroll
    for (int i = 0; i < 2; ++i) {
        const int idx = tid + i * 512, r = idx >> 4, c4 = idx & 15;
        const f32x4 v = *(const f32x4*)(W + (size_t)(k0 + r) * N + n0 + 4 * c4);
        t[r * 65 + 4 * c4 + 0] = v.x; t[r * 65 + 4 * c4 + 1] = v.y; t[r * 65 + 4 * c4 + 2] = v.z; t[r * 65 + 4 * c4 + 3] = v.w;
    }
    __syncthreads();
    {
        const int n = tid >> 3, kc = tid & 7;
        const LAS float* s = t + (8 * kc) * 65 + n;
        u32x4 o; o.x = cvt_pk_bf16(s[0], s[65]); o.y = cvt_pk_bf16(s[130], s[195]); o.z = cvt_pk_bf16(s[260], s[325]); o.w = cvt_pk_bf16(s[390], s[455]);
        int nn = n0 + n;
        if (perm) { const int L = nn & 255, wc = L >> 6, bj = (L >> 5) & 1, c32 = L & 31; nn = (nn & ~255) + 128 * bj + 32 * wc + c32; }
        *(u32x4*)(Wt + (size_t)nn * K + k0 + 8 * kc) = o;
    }
    __syncthreads();
}

DI void phase_prologue(const PV& p, LAS unsigned char* lds) {
    LAS float* t = (LAS float*)lds;
    unsigned char* ws = p.ws;
    constexpr int T_ADA = 16 * 96, T_IN = 16 * 24, T_O = 16 * 16, T_UP = 16 * 88, T_DN = 44 * 16;
    constexpr int PER_L = T_ADA + T_IN + T_O + T_UP + T_DN;
    for (int it = p.bid; it < 4 * PER_L; it += p.nb) {
        const int l = it / PER_L; int r = it - l * PER_L;
        if (r < T_ADA) { tr_tile(p, p.in_(I_WADA) + (size_t)l * DM * NMOD, DM, NMOD, (bf16_t*)(ws + W_WTADA) + (size_t)l * NMOD * DM, r, false, t); continue; } r -= T_ADA;
        if (r < T_IN) { tr_tile(p, p.in_(I_WIN) + (size_t)l * DM * DIN, DM, DIN, (bf16_t*)(ws + W_WTIN) + (size_t)l * DIN * DM, r, true, t); continue; } r -= T_IN;
        if (r < T_O) { tr_tile(p, p.in_(I_WO) + (size_t)l * DM * DM, DM, DM, (bf16_t*)(ws + W_WTO) + (size_t)l * DM * DM, r, false, t); continue; } r -= T_O;
        if (r < T_UP) { tr_tile(p, p.in_(I_WUP) + (size_t)l * DM * DUP, DM, DUP, (bf16_t*)(ws + W_WTUP) + (size_t)l * DUP * DM, r, false, t); continue; } r -= T_UP;
        tr_tile(p, p.in_(I_WDN) + (size_t)l * DFF * DM, DFF, DM, (bf16_t*)(ws + W_WTDN) + (size_t)l * DM * DFF, r, false, t);
    }
    const int gt = p.bid * 512 + p.tid, GT = p.nb * 512;
    bf16_t* cs = (bf16_t*)(ws + W_CSILU);
    for (int i = gt; i < 256 * DM; i += GT) {
        const int r = i >> 10, k = i & 1023; float v = 0.f;
        if (r < 4) v = p.in_(I_CP)[r * DM + k]; else if (r < NSEQ) v = p.in_(I_CS)[(r - 4) * DM + k];
        cs[i] = f2bf(v / (1.f + __expf(-v)));
    }
    float* rc = (float*)(ws + W_ROTC); float* rs = (float*)(ws + W_ROTS);
    for (int i = gt; i < 4100 * 32; i += GT) {
        const int pi = i >> 5, j = i & 31; const double pos = pi < 4096 ? (double)pi : (double)(8192 + pi - 4096);
        const double inv = exp(-(double)j * (1.0 / 32.0) * 9.210340371976184);
        const double ang = pos * inv; rc[i] = (float)cos(ang); rs[i] = (float)sin(ang);
    }
    float* abar = (float*)(ws + W_ABAR); float* bb = (float*)(ws + W_BB);
    for (int i = gt; i < 4 * 16 * 64; i += GT) {
        const int l = i >> 10, g = (i >> 6) & 15, s = i & 63;
        const double are = p.in_(I_ARE)[i], aim = p.in_(I_AIM)[i], dt = exp((double)p.in_(I_LDT)[l * 16 + g]);
        const double mag = exp(are * dt), abr = mag * cos(aim * dt), abi = mag * sin(aim * dt);
        abar[2 * i] = (float)abr; abar[2 * i + 1] = (float)abi;
        const double nr = abr - 1.0, ni = abi, den = are * are + aim * aim;
        const double fr_ = (nr * are + ni * aim) / den, fi_ = (ni * are - nr * aim) / den;
        for (int c = 0; c < 16; ++c) {
            const double br = p.in_(I_BRE)[(size_t)i * 16 + c], bi = p.in_(I_BIM)[(size_t)i * 16 + c];
            bb[(((size_t)(l * 16 + g) * 2 + 0) * 64 + s) * 16 + c] = (float)(fr_ * br - fi_ * bi);
            bb[(((size_t)(l * 16 + g) * 2 + 1) * 64 + s) * 16 + c] = (float)(fr_ * bi + fi_ * br);
        }
    }
}

DI void phase_norm(const PV& p, const float* xp, const float* xs_adj, const float* w, const float* mod_sh, bf16_t* H) {
    const int wave = p.tid >> 6, lane = p.tid & 63;
    for (int row = p.bid * 8 + wave; row < NTOK; row += p.nb * 8) {
        const float* x = (row < NP ? xp : xs_adj) + (size_t)row * DM;
        const float* sh = mod_sh + (size_t)seq_of(row) * NMODALL; const float* sc = sh + DM;
        f32x4 v[4]; float ss = 0.f;
#pragma unroll
        for (int j = 0; j < 4; ++j) { v[j] = *(const f32x4*)(x + 256 * j + 4 * lane); ss += v[j].x * v[j].x + v[j].y * v[j].y + v[j].z * v[j].z + v[j].w * v[j].w; }
        const float rinv = rsqrtf(wave_sum(ss) * (1.f / DM) + EPS);
#pragma unroll
        for (int j = 0; j < 4; ++j) {
            const int c = 256 * j + 4 * lane;
            const f32x4 ww = *(const f32x4*)(w + c), s1 = *(const f32x4*)(sc + c), s0 = *(const f32x4*)(sh + c);
            const f32x4 o = v[j] * rinv * ww * (s1 + 1.f) + s0;
            u32x2 a; a.x = cvt_pk_bf16(o.x, o.y); a.y = cvt_pk_bf16(o.z, o.w);
            *(u32x2*)(H + (size_t)row * DM + c) = a;
        }
    }
}

DI void phase_convglu(const PV& p, int layer) {
    const bf16_t* UP = (const bf16_t*)(p.ws + W_UP); bf16_t* ACT = (bf16_t*)(p.ws + W_ACT);
    const float* cw = p.in_(I_FCW) + (size_t)layer * 3 * DUP; const float* cb = p.in_(I_FCB) + (size_t)layer * DUP;
    const float* st = p.in_(I_SFC) + (size_t)layer * 128 * 2 * DUP;
    constexpr int NCG = DFF / 4;
    const long total = (long)(NTOK / 4) * NCG;
    for (long it = (long)p.bid * 512 + p.tid; it < total; it += (long)p.nb * 512) {
        const int run = (int)(it / NCG), cg4 = (int)(it - (long)run * NCG), c = cg4 * 4, row0 = run * 4;
        f32x4 w[2][3], bias[2];
#pragma unroll
        for (int h = 0; h < 2; ++h) { bias[h] = *(const f32x4*)(cb + h * DFF + c);
#pragma unroll
            for (int j = 0; j < 3; ++j) w[h][j] = *(const f32x4*)(cw + j * DUP + h * DFF + c); }
        f32x4 xm2[2], xm1[2];
        const bool prm = row0 < NP;
#pragma unroll
        for (int h = 0; h < 2; ++h) {
            if (prm) {
                if ((row0 & 4095) == 0) { xm2[h] = (f32x4){0.f, 0.f, 0.f, 0.f}; xm1[h] = xm2[h]; }
                else {
                    const u32x2 a = *(const u32x2*)(UP + (size_t)(row0 - 2) * DUP + h * DFF + c), b = *(const u32x2*)(UP + (size_t)(row0 - 1) * DUP + h * DFF + c);
                    xm2[h] = (f32x4){__uint_as_float(a.x << 16), __uint_as_float(a.x & 0xffff0000u), __uint_as_float(a.y << 16), __uint_as_float(a.y & 0xffff0000u)};
                    xm1[h] = (f32x4){__uint_as_float(b.x << 16), __uint_as_float(b.x & 0xffff0000u), __uint_as_float(b.y << 16), __uint_as_float(b.y & 0xffff0000u)};
                }
            } else {
                const int sq = (row0 - NP) >> 2;
                xm2[h] = *(const f32x4*)(st + ((size_t)sq * 2 + 0) * DUP + h * DFF + c);
                xm1[h] = *(const f32x4*)(st + ((size_t)sq * 2 + 1) * DUP + h * DFF + c);
            }
        }
#pragma unroll
        for (int t = 0; t < 4; ++t) {
            f32x4 y[2];
#pragma unroll
            for (int h = 0; h < 2; ++h) {
                const u32x2 a = *(const u32x2*)(UP + (size_t)(row0 + t) * DUP + h * DFF + c);
                const f32x4 x0 = (f32x4){__uint_as_float(a.x << 16), __uint_as_float(a.x & 0xffff0000u), __uint_as_float(a.y << 16), __uint_as_float(a.y & 0xffff0000u)};
                y[h] = bias[h] + w[h][0] * xm2[h] + w[h][1] * xm1[h] + w[h][2] * x0;
                xm2[h] = xm1[h]; xm1[h] = x0;
            }
            u32x2 o; o.x = cvt_pk_bf16(gelu_t(y[0].x) * y[1].x, gelu_t(y[0].y) * y[1].y); o.y = cvt_pk_bf16(gelu_t(y[0].z) * y[1].z, gelu_t(y[0].w) * y[1].w);
            *(u32x2*)(ACT + (size_t)(row0 + t) * DFF + c) = o;
        }
    }
}

constexpr int KS_STR = 72, VT_STR = 280, PS_STR = 168;
DI void attn_prompt_item(const PV& p, int layer, int item, LAS unsigned char* lds) {
    const int tid = p.tid, wave = tid >> 6, lane = tid & 63, sub = lane & 15, q = lane >> 4;
    const int b = item >> 6, qblk = (item >> 1) & 31, kvh = item & 1;
    const bf16_t* Q = (const bf16_t*)(p.ws + W_Q); const bf16_t* Kb = (const bf16_t*)(p.ws + W_KB); const bf16_t* Vb = (const bf16_t*)(p.ws + W_VB);
    float* OATT = (float*)(p.ws + W_OATT);
    LAS bf16_t* Ks = (LAS bf16_t*)lds;
    LAS bf16_t* Vt = Ks + 256 * KS_STR;
    LAS bf16_t* Ps = Vt + 64 * VT_STR + wave * 16 * PS_STR;
    const int tok0 = b * 4096 + qblk * 128;
    {
        const int key = tid >> 1, hf = tid & 1; const bool valid = (qblk > 0) || key >= 128;
        u32x4 v[4];
#pragma unroll
        for (int i = 0; i < 4; ++i) v[i] = valid ? *(const u32x4*)(Kb + (size_t)(tok0 - 128 + key) * 128 + kvh * 64 + hf * 32 + 8 * i) : (u32x4){0u, 0u, 0u, 0u};
#pragma unroll
        for (int i = 0; i < 4; ++i) *(LAS u32x4*)(Ks + key * KS_STR + hf * 32 + 8 * i) = v[i];
    }
    {
        const int key = tid & 255, dh = tid >> 8; const bool valid = (qblk > 0) || key >= 128;
        u32x4 v[4];
#pragma unroll
        for (int i = 0; i < 4; ++i) v[i] = valid ? *(const u32x4*)(Vb + (size_t)(tok0 - 128 + key) * 128 + kvh * 64 + dh * 32 + 8 * i) : (u32x4){0u, 0u, 0u, 0u};
#pragma unroll
        for (int i = 0; i < 4; ++i) {
            const unsigned wv[4] = {v[i].x, v[i].y, v[i].z, v[i].w};
#pragma unroll
            for (int j = 0; j < 4; ++j) {
                Vt[(dh * 32 + 8 * i + 2 * j) * VT_STR + key] = (bf16_t)(wv[j] & 0xffffu);
                Vt[(dh * 32 + 8 * i + 2 * j + 1) * VT_STR + key] = (bf16_t)(wv[j] >> 16);
            }
        }
        if (tid < 64) { for (int c = 256; c < VT_STR; ++c) Vt[tid * VT_STR + c] = 0; }
    }
    for (int i = lane; i < 16 * 24; i += 64) Ps[(i / 24) * PS_STR + 144 + (i % 24)] = 0;
    __syncthreads();
    const int qloc0 = 16 * wave;
#pragma unroll 1
    for (int hh = 0; hh < 4; ++hh) {
        const int head = kvh * 4 + hh;
        int subm = sub; asm volatile("" : "+v"(subm));
        const float sink = p.in_(I_SINK)[layer * 8 + head];
        bf16x8 qf[2];
#pragma unroll
        for (int s = 0; s < 2; ++s) qf[s] = *(const bf16x8*)(Q + (size_t)(tok0 + qloc0 + sub) * 512 + head * 64 + 32 * s + 8 * q);
        f32x4 S[9];
#pragma unroll
        for (int jt = 0; jt < 9; ++jt) {
            f32x4 a = {0.f, 0.f, 0.f, 0.f};
#pragma unroll
            for (int s = 0; s < 2; ++s) {
                const bf16x8 kf = *(const LAS bf16x8*)(Ks + (16 * (wave + jt) + sub) * KS_STR + 32 * s + 8 * q);
                a = MFMA16(qf[s], kf, a);
            }
            S[jt] = a;
        }
        float mx[4], sm[4];
#pragma unroll
        for (int r = 0; r < 4; ++r) {
            const int i = qloc0 + 4 * q + r; float m = -INFINITY;
#pragma unroll
            for (int jt = 0; jt < 9; ++jt) {
                const int j = 16 * (wave + jt) + subm;
                const bool ok = (j >= i + 1) && (j <= i + 128) && (qblk > 0 || j >= 128);
                const float v = ok ? S[jt][r] : -INFINITY; S[jt][r] = v; m = fmaxf(m, v);
            }
            m = fmaxf(max16(m), sink); mx[r] = m;
            float s = 0.f;
#pragma unroll
            for (int jt = 0; jt < 9; ++jt) { const float e = __expf(S[jt][r] - m); S[jt][r] = e; s += e; }
            sm[r] = 1.f / (sum16(s) + __expf(sink - m));
        }
#pragma unroll
        for (int jt = 0; jt < 9; ++jt)
#pragma unroll
            for (int r = 0; r < 4; ++r) Ps[(4 * q + r) * PS_STR + 16 * jt + sub] = f2bf(S[jt][r]);
        __syncthreads();
        f32x4 O[4];
#pragma unroll
        for (int dt = 0; dt < 4; ++dt) O[dt] = (f32x4){0.f, 0.f, 0.f, 0.f};
#pragma unroll
        for (int s = 0; s < 5; ++s) {
            const bf16x8 pf = *(const LAS bf16x8*)(Ps + sub * PS_STR + 32 * s + 8 * q);
#pragma unroll
            for (int dt = 0; dt < 4; ++dt) {
                const bf16x8 vf = *(const LAS bf16x8*)(Vt + (16 * dt + sub) * VT_STR + 16 * wave + 32 * s + 8 * q);
                O[dt] = MFMA16(pf, vf, O[dt]);
            }
        }
#pragma unroll
        for (int dt = 0; dt < 4; ++dt)
#pragma unroll
            for (int r = 0; r < 4; ++r) OATT[(size_t)(tok0 + qloc0 + 4 * q + r) * 512 + head * 64 + 16 * dt + sub] = O[dt][r] * sm[r];
        __syncthreads();
    }
    __syncthreads();
}

DI void attn_sample_item(const PV& p, int layer, int item, LAS unsigned char* lds) {
    const int tid = p.tid, s = item >> 1, kvh = item & 1;
    const bf16_t* Q = (const bf16_t*)(p.ws + W_Q); const bf16_t* Kb = (const bf16_t*)(p.ws + W_KB); const bf16_t* Vb = (const bf16_t*)(p.ws + W_VB);
    float* OATT = (float*)(p.ws + W_OATT);
    LAS float* Kf = (LAS float*)lds;
    LAS float* Vf = Kf + 132 * 65;
    LAS float* Qs = Vf + 132 * 64;
    LAS float* Sc = Qs + 16 * 64;
    const float* ck = p.in_(I_CK) + ((size_t)(layer * 128 + s) * 128) * 128 + kvh * 64;
    const float* cv = p.in_(I_CV) + ((size_t)(layer * 128 + s) * 128) * 128 + kvh * 64;
    float* sk = p.out + O_SK + ((size_t)(layer * 128 + s) * 128) * 128 + kvh * 64;
    float* sv = p.out + O_SV + ((size_t)(layer * 128 + s) * 128) * 128 + kvh * 64;
    for (int i = tid; i < 132 * 64; i += 512) {
        const int j = i >> 6, d = i & 63; float kv, vv;
        if (j < 128) { kv = ck[(size_t)j * 128 + d]; vv = cv[(size_t)j * 128 + d]; if (j >= 4) { sk[(size_t)(j - 4) * 128 + d] = kv; sv[(size_t)(j - 4) * 128 + d] = vv; } }
        else { const size_t rw = (size_t)(NP + 4 * s + (j - 128)) * 128 + kvh * 64 + d; kv = bf2f(Kb[rw]); vv = bf2f(Vb[rw]); }
        Kf[j * 65 + d] = kv; Vf[j * 64 + d] = vv;
    }
    for (int i = tid; i < 16 * 64; i += 512) { const int rr = i >> 6, d = i & 63, hh = rr >> 2, t = rr & 3; Qs[i] = bf2f(Q[(size_t)(NP + 4 * s + t) * 512 + (kvh * 4 + hh) * 64 + d]); }
    __syncthreads();
    const int rr = tid >> 5, jl = tid & 31, hh = rr >> 2, t = rr & 3;
    const float sink = p.in_(I_SINK)[layer * 8 + kvh * 4 + hh];
    float sc[5]; float m = -INFINITY;
#pragma unroll
    for (int it = 0; it < 5; ++it) {
        __builtin_amdgcn_sched_barrier(0);
        const int j = jl + 32 * it; float a = -INFINITY;
        if (j < 132 && j >= t + 1 && j <= t + 128) { a = 0.f;
#pragma unroll 8
            for (int d = 0; d < 64; ++d) a += Qs[rr * 64 + d] * Kf[j * 65 + d]; }
        sc[it] = a; m = fmaxf(m, a);
    }
#pragma unroll
    for (int o = 1; o < 32; o <<= 1) m = fmaxf(m, __shfl_xor(m, o));
    m = fmaxf(m, sink);
    float sum = 0.f;
#pragma unroll
    for (int it = 0; it < 5; ++it) { const float e = __expf(sc[it] - m); sc[it] = e; sum += e; }
#pragma unroll
    for (int o = 1; o < 32; o <<= 1) sum += __shfl_xor(sum, o);
    const float inv = 1.f / (sum + __expf(sink - m));
#pragma unroll
    for (int it = 0; it < 5; ++it) { const int j = jl + 32 * it; if (j < 132) Sc[rr * 136 + j] = sc[it] * inv; }
    __syncthreads();
#pragma unroll
    for (int dd = 0; dd < 2; ++dd) {
        const int d = jl + 32 * dd; float a = 0.f;
#pragma unroll 4
        for (int j = 0; j < 132; ++j) a += Sc[rr * 136 + j] * Vf[j * 64 + d];
        OATT[(size_t)(NP + 4 * s + t) * 512 + (kvh * 4 + hh) * 64 + d] = a;
    }
    __syncthreads();
}


DI void attn_prompt4_item(const PV& p, int layer, int item, LAS unsigned char* lds) {
    const int tid = p.tid, kvh = item & 1, grp = (item >> 1) & 1023, b = item >> 11;
    const bf16_t* Q = (const bf16_t*)(p.ws + W_Q); const bf16_t* Kb = (const bf16_t*)(p.ws + W_KB); const bf16_t* Vb = (const bf16_t*)(p.ws + W_VB);
    float* OATT = (float*)(p.ws + W_OATT);
    LAS float* Kf = (LAS float*)lds;
    LAS float* Vf = Kf + 132 * 65;
    LAS float* Qs = Vf + 132 * 64;
    LAS float* Sc = Qs + 16 * 64;
    const int r0 = b * 4096 + 4 * grp, p0 = 4 * grp;
    for (int i = tid; i < 132 * 64; i += 512) {
        const int j = i >> 6, d = i & 63; float kv = 0.f, vv = 0.f;
        if (p0 - 128 + j >= 0) { const size_t rw = (size_t)(r0 - 128 + j) * 128 + kvh * 64 + d; kv = bf2f(Kb[rw]); vv = bf2f(Vb[rw]); }
        Kf[j * 65 + d] = kv; Vf[j * 64 + d] = vv;
    }
    for (int i = tid; i < 16 * 64; i += 512) { const int rr = i >> 6, d = i & 63, hh = rr >> 2, t = rr & 3; Qs[i] = bf2f(Q[(size_t)(r0 + t) * 512 + (kvh * 4 + hh) * 64 + d]); }
    __syncthreads();
    const int rr = tid >> 5, jl = tid & 31, hh = rr >> 2, t = rr & 3;
    const float sink = p.in_(I_SINK)[layer * 8 + kvh * 4 + hh];
    float sc[5]; float m = -INFINITY;
#pragma unroll
    for (int it = 0; it < 5; ++it) {
        __builtin_amdgcn_sched_barrier(0);
        const int j = jl + 32 * it; float a = -INFINITY;
        if (j < 132 && j >= t + 1 && j <= t + 128 && p0 - 128 + j >= 0) { a = 0.f;
#pragma unroll 8
            for (int d = 0; d < 64; ++d) a += Qs[rr * 64 + d] * Kf[j * 65 + d]; }
        sc[it] = a; m = fmaxf(m, a);
    }
#pragma unroll
    for (int o = 1; o < 32; o <<= 1) m = fmaxf(m, __shfl_xor(m, o));
    m = fmaxf(m, sink);
    float sum = 0.f;
#pragma unroll
    for (int it = 0; it < 5; ++it) { const float e = __expf(sc[it] - m); sc[it] = e; sum += e; }
#pragma unroll
    for (int o = 1; o < 32; o <<= 1) sum += __shfl_xor(sum, o);
    const float inv = 1.f / (sum + __expf(sink - m));
#pragma unroll
    for (int it = 0; it < 5; ++it) { const int j = jl + 32 * it; if (j < 132) Sc[rr * 136 + j] = sc[it] * inv; }
    __syncthreads();
#pragma unroll
    for (int dd = 0; dd < 2; ++dd) {
        const int d = jl + 32 * dd; float a = 0.f;
#pragma unroll 4
        for (int j = 0; j < 132; ++j) a += Sc[rr * 136 + j] * Vf[j * 64 + d];
        OATT[(size_t)(r0 + t) * 512 + (kvh * 4 + hh) * 64 + d] = a;
    }
    __syncthreads();
}

DI void attn_prompt16_item(const PV& p, int layer, int item, LAS unsigned char* lds) {
    const int tid = p.tid, kvh = item & 1, grp = (item >> 1) & 255, b = item >> 9;
    const bf16_t* Q = (const bf16_t*)(p.ws + W_Q); const bf16_t* Kb = (const bf16_t*)(p.ws + W_KB); const bf16_t* Vb = (const bf16_t*)(p.ws + W_VB);
    float* OATT = (float*)(p.ws + W_OATT);
    LAS float* Kf = (LAS float*)lds;
    LAS float* Vf = Kf + 144 * 68;
    LAS float* Qs = Vf + 144 * 64;
    LAS float* Sc = Qs + 64 * 64;
    const int p0 = 16 * grp, r0 = b * 4096 + p0;
    for (int i = tid; i < 144 * 8; i += 512) {
        const int j = i >> 3, c8 = (i & 7) * 8;
        u32x4 kk = {0u, 0u, 0u, 0u}, vv = kk;
        if (p0 - 128 + j >= 0) { const size_t rw = (size_t)(r0 - 128 + j) * 128 + kvh * 64 + c8; kk = *(const u32x4*)(Kb + rw); vv = *(const u32x4*)(Vb + rw); }
        *(LAS f32x4*)(Kf + j * 68 + c8) = (f32x4){__uint_as_float(kk.x << 16), __uint_as_float(kk.x & 0xffff0000u), __uint_as_float(kk.y << 16), __uint_as_float(kk.y & 0xffff0000u)};
        *(LAS f32x4*)(Kf + j * 68 + c8 + 4) = (f32x4){__uint_as_float(kk.z << 16), __uint_as_float(kk.z & 0xffff0000u), __uint_as_float(kk.w << 16), __uint_as_float(kk.w & 0xffff0000u)};
        *(LAS f32x4*)(Vf + j * 64 + c8) = (f32x4){__uint_as_float(vv.x << 16), __uint_as_float(vv.x & 0xffff0000u), __uint_as_float(vv.y << 16), __uint_as_float(vv.y & 0xffff0000u)};
        *(LAS f32x4*)(Vf + j * 64 + c8 + 4) = (f32x4){__uint_as_float(vv.z << 16), __uint_as_float(vv.z & 0xffff0000u), __uint_as_float(vv.w << 16), __uint_as_float(vv.w & 0xffff0000u)};
    }
    for (int i = tid; i < 64 * 8; i += 512) {
        const int rr = i >> 3, c8 = (i & 7) * 8, hh = rr >> 4, t = rr & 15;
        const u32x4 qq = *(const u32x4*)(Q + (size_t)(r0 + t) * 512 + (kvh * 4 + hh) * 64 + c8);
        *(LAS f32x4*)(Qs + rr * 64 + c8) = (f32x4){__uint_as_float(qq.x << 16), __uint_as_float(qq.x & 0xffff0000u), __uint_as_float(qq.y << 16), __uint_as_float(qq.y & 0xffff0000u)};
        *(LAS f32x4*)(Qs + rr * 64 + c8 + 4) = (f32x4){__uint_as_float(qq.z << 16), __uint_as_float(qq.z & 0xffff0000u), __uint_as_float(qq.w << 16), __uint_as_float(qq.w & 0xffff0000u)};
    }
    __syncthreads();
    const int rr = tid >> 3, jl = tid & 7, hh = rr >> 4, t = rr & 15;
    const float sink = p.in_(I_SINK)[layer * 8 + kvh * 4 + hh];
    float sc[18]; float m = -INFINITY;
    f32x4 qr[16];
#pragma unroll
    for (int d4 = 0; d4 < 16; ++d4) qr[d4] = *(const LAS f32x4*)(Qs + rr * 64 + 4 * d4);
#pragma unroll
    for (int it = 0; it < 18; ++it) {
        const int j = jl + 8 * it; float a = -INFINITY;
        if (j >= t + 1 && j <= t + 128 && p0 - 128 + j >= 0) { f32x4 a4 = {0.f, 0.f, 0.f, 0.f};
#pragma unroll
            for (int d4 = 0; d4 < 16; ++d4) a4 += qr[d4] * *(const LAS f32x4*)(Kf + j * 68 + 4 * d4);
            a = (a4.x + a4.y) + (a4.z + a4.w); }
        sc[it] = a; m = fmaxf(m, a);
    }
#pragma unroll
    for (int o = 1; o < 8; o <<= 1) m = fmaxf(m, __shfl_xor(m, o));
    m = fmaxf(m, sink);
    float sum = 0.f;
#pragma unroll
    for (int it = 0; it < 18; ++it) { const float e = __expf(sc[it] - m); sc[it] = e; sum += e; }
#pragma unroll
    for (int o = 1; o < 8; o <<= 1) sum += __shfl_xor(sum, o);
    const float inv = 1.f / (sum + __expf(sink - m));
#pragma unroll
    for (int it = 0; it < 18; ++it) Sc[rr * 148 + jl + 8 * it] = sc[it] * inv;
    __syncthreads();
    f32x4 oa = {0.f, 0.f, 0.f, 0.f}, ob = oa;
#pragma unroll 4
    for (int j = 0; j < 144; ++j) {
        const float pj = Sc[rr * 148 + j];
        oa += *(const LAS f32x4*)(Vf + j * 64 + 8 * jl) * pj; ob += *(const LAS f32x4*)(Vf + j * 64 + 8 * jl + 4) * pj;
    }
    { float* op = OATT + (size_t)(r0 + t) * 512 + (kvh * 4 + hh) * 64 + 8 * jl; *(f32x4*)op = oa; *(f32x4*)(op + 4) = ob; }
    __syncthreads();
}
DI void attn_norm_item(const PV& p, int layer, int item) {
    const int wave = p.tid >> 6, lane = p.tid & 63;
    const float* OATT = (const float*)(p.ws + W_OATT); bf16_t* O = (bf16_t*)(p.ws + W_O);
    const float* on = p.in_(I_ON) + layer * DM;
    for (int rr = wave; rr < 256; rr += 8) {
        const int row = item * 256 + rr;
        const f32x4 a = *(const f32x4*)(OATT + (size_t)row * 512 + 4 * lane), b = *(const f32x4*)(OATT + (size_t)row * 512 + 256 + 4 * lane);
        float ss = a.x * a.x + a.y * a.y + a.z * a.z + a.w * a.w + b.x * b.x + b.y * b.y + b.z * b.z + b.w * b.w;
        const float rinv = rsqrtf(wave_sum(ss) * (1.f / 512.f) + EPS);
        const f32x4 wa = *(const f32x4*)(on + 4 * lane), wb = *(const f32x4*)(on + 256 + 4 * lane);
        const f32x4 oa = a * rinv * wa, ob = b * rinv * wb;
        u32x2 x; x.x = cvt_pk_bf16(oa.x, oa.y); x.y = cvt_pk_bf16(oa.z, oa.w); *(u32x2*)(O + (size_t)row * DM + 4 * lane) = x;
        u32x2 y; y.x = cvt_pk_bf16(ob.x, ob.y); y.y = cvt_pk_bf16(ob.z, ob.w); *(u32x2*)(O + (size_t)row * DM + 256 + 4 * lane) = y;
    }
}

struct cpx { float re, im; };
DI cpx cmul(cpx a, cpx b) { return cpx{a.re * b.re - a.im * b.im, a.re * b.im + a.im * b.re}; }
DI cpx cfma(cpx a, cpx x, cpx y) { return cpx{a.re * x.re - a.im * x.im + y.re, a.re * x.im + a.im * x.re + y.im}; }

template <bool SAMPLE, bool PASS2>
DI void ssm_item(const PV& p, int layer, int item, LAS unsigned char* lds) {
    const int tid = p.tid, wave = tid >> 6, lane = tid & 63, sub = lane & 15, q = lane >> 4;
    int row0, b = 0, c = 0;
    if (SAMPLE) row0 = NP + item * 64; else { b = item >> 6; c = item & 63; row0 = b * 4096 + c * 64; }
    const float* U = (const float*)(p.ws + W_U);
    const float* ABAR = (const float*)(p.ws + W_ABAR); const float* BB = (const float*)(p.ws + W_BB);
    float* SST = (float*)(p.ws + W_SST);
    LAS bf16_t* Hs = (LAS bf16_t*)lds + wave * 16 * 136;
    LAS bf16_t* Gs = (LAS bf16_t*)lds + 8 * 16 * 136;
    LAS float* rowss = (LAS float*)(Gs + 64 * 264);
    if (PASS2) { if (tid < 64) rowss[tid] = 0.f; }
#pragma unroll 1
    for (int gi = 0; gi < 2; ++gi) {
        const int g = 2 * wave + gi, lg = layer * 16 + g;
        cpx a[4], a4[4], hin[4];
        bf16x8 Bf[8], Cf[4];
#pragma unroll
        for (int i = 0; i < 4; ++i) {
            const int st = 16 * i + sub;
            a[i] = cpx{ABAR[((size_t)lg * 64 + st) * 2], ABAR[((size_t)lg * 64 + st) * 2 + 1]};
            const cpx a2 = cmul(a[i], a[i]); a4[i] = cmul(a2, a2);
            hin[i] = cpx{0.f, 0.f};
#pragma unroll
            for (int part = 0; part < 2; ++part) {
                f32x4 v0 = {0.f, 0.f, 0.f, 0.f}, v1 = v0;
                if (q < 2) { const float* src = BB + (((size_t)lg * 2 + part) * 64 + st) * 16 + 8 * q; v0 = *(const f32x4*)src; v1 = *(const f32x4*)(src + 4); }
                Bf[2 * i + part] = pack8(v0, v1);
            }
        }
#pragma unroll
        for (int s = 0; s < 4; ++s) {
            const int part = q >> 1, p0 = 16 * s + 8 * (q & 1);
            const float* src = (part ? p.in_(I_CIM) : p.in_(I_CRE)) + ((size_t)lg * 16 + sub) * 64 + p0;
            f32x4 v0 = *(const f32x4*)src, v1 = *(const f32x4*)(src + 4);
            if (part) { v0 = -v0; v1 = -v1; }
            Cf[s] = pack8(v0, v1);
        }
        if (PASS2 && !SAMPLE) {
            cpx a64[4], hh4[4];
#pragma unroll
            for (int i = 0; i < 4; ++i) { const cpx a8 = cmul(a4[i], a4[i]), a16 = cmul(a8, a8), a32 = cmul(a16, a16); a64[i] = cmul(a32, a32); hh4[i] = cpx{0.f, 0.f}; }
            const float* sp0 = SST + (((size_t)(b * 64) * 16 + g) * 64 + sub) * 2;
#pragma unroll 1
            for (int j0 = 0; j0 < c; j0 += 4) {
                float2 sv[4][4];
#pragma unroll
                for (int u = 0; u < 4; ++u)
#pragma unroll
                    for (int i = 0; i < 4; ++i) { const int jj = (j0 + u < c) ? j0 + u : c - 1; sv[u][i] = *(const float2*)(sp0 + (size_t)jj * 2048 + i * 32); }
#pragma unroll
                for (int u = 0; u < 4; ++u)
                    if (j0 + u < c) {
#pragma unroll
                        for (int i = 0; i < 4; ++i) hh4[i] = cfma(a64[i], hh4[i], cpx{sv[u][i].x, sv[u][i].y});
                    }
            }
#pragma unroll
            for (int i = 0; i < 4; ++i) hin[i] = hh4[i];
        }
        const float dcoef = p.in_(I_SD)[layer * 256 + g * 16 + sub];
#pragma unroll 1
        for (int tt = 0; tt < 4; ++tt) {
            f32x4 u0 = {0.f, 0.f, 0.f, 0.f}, u1 = u0;
            if (q < 2) { const float* src = U + (size_t)(row0 + 16 * tt + sub) * 256 + g * 16 + 8 * q; u0 = *(const f32x4*)src; u1 = *(const f32x4*)(src + 4); }
            const bf16x8 Uf = pack8(u0, u1);
            f32x4 acc[8];
#pragma unroll
            for (int n = 0; n < 8; ++n) acc[n] = MFMA16(Uf, Bf[n], ((f32x4){0.f, 0.f, 0.f, 0.f}));
#pragma unroll
            for (int i = 0; i < 4; ++i) {
                const int st = 16 * i + sub;
                cpx bu[4];
#pragma unroll
                for (int r = 0; r < 4; ++r) bu[r] = cpx{acc[2 * i][r], acc[2 * i + 1][r]};
                cpx in;
                if (SAMPLE) {
                    const int sq = (row0 - NP) / 4 + 4 * tt + q;
                    const size_t so = ((size_t)(layer * 128 + sq) * 16 + g) * 64 + st;
                    in = cpx{p.in_(I_SRE)[so], p.in_(I_SIM)[so]};
                } else {
                    cpx x = bu[0]; x = cfma(a[i], x, bu[1]); x = cfma(a[i], x, bu[2]); x = cfma(a[i], x, bu[3]);
                    cpx e[4];
#pragma unroll
                    for (int k = 0; k < 4; ++k) e[k] = cpx{__shfl(x.re, sub + 16 * k), __shfl(x.im, sub + 16 * k)};
                    const cpx E0 = cfma(a4[i], hin[i], e[0]), E1 = cfma(a4[i], E0, e[1]), E2 = cfma(a4[i], E1, e[2]), E3 = cfma(a4[i], E2, e[3]);
                    in = q == 0 ? hin[i] : (q == 1 ? E0 : (q == 2 ? E1 : E2));
                    hin[i] = E3;
                }
                if (PASS2) {
                    cpx h = in;
#pragma unroll
                    for (int r = 0; r < 4; ++r) {
                        h = cfma(a[i], h, bu[r]);
                        Hs[(4 * q + r) * 136 + (2 * i) * 16 + sub] = f2bf(h.re);
                        Hs[(4 * q + r) * 136 + (2 * i + 1) * 16 + sub] = f2bf(h.im);
                    }
                    if (SAMPLE) {
                        const int sq = (row0 - NP) / 4 + 4 * tt + q;
                        const size_t so = ((size_t)(layer * 128 + sq) * 16 + g) * 64 + st;
                        p.out[O_SRE + so] = h.re; p.out[O_SIM + so] = h.im;
                    }
                }
            }
            if (PASS2) {
                __builtin_amdgcn_wave_barrier(); asm volatile("s_waitcnt lgkmcnt(0)" ::: "memory");
                f32x4 Y = {0.f, 0.f, 0.f, 0.f};
#pragma unroll
                for (int s = 0; s < 4; ++s) { const bf16x8 hf = *(const LAS bf16x8*)(Hs + sub * 136 + 32 * s + 8 * q); Y = MFMA16(hf, Cf[s], Y); }
#pragma unroll
                for (int r = 0; r < 4; ++r) {
                    const int t = 16 * tt + 4 * q + r;
                    const float uu = U[(size_t)(row0 + t) * 256 + g * 16 + sub];
                    const float gg = gelu_t(Y[r] + dcoef * uu);
                    Gs[t * 264 + g * 16 + sub] = f2bf(gg);
                }
                __builtin_amdgcn_wave_barrier(); asm volatile("s_waitcnt lgkmcnt(0)" ::: "memory");
            }
        }
        if (!SAMPLE && q == 0) {
#pragma unroll
            for (int i = 0; i < 4; ++i) {
                const int st = 16 * i + sub;
                if (!PASS2) { float* sp = SST + (((size_t)(b * 64 + c) * 16 + g) * 64 + st) * 2; sp[0] = hin[i].re; sp[1] = hin[i].im; }
                else if (c == 63) { const size_t so = ((size_t)(layer * 4 + b) * 16 + g) * 64 + st; p.out[O_PRE + so] = hin[i].re; p.out[O_PIM + so] = hin[i].im; }
            }
        }
    }
    if (PASS2) {
        __syncthreads();
        f32x4 z[2][4];
#pragma unroll
        for (int n2 = 0; n2 < 2; ++n2)
#pragma unroll
            for (int mt = 0; mt < 4; ++mt) z[n2][mt] = (f32x4){0.f, 0.f, 0.f, 0.f};
        const float* wg = p.in_(I_WGLU) + (size_t)layer * 256 * 256;
#pragma unroll 2
        for (int s = 0; s < 8; ++s) {
            bf16x8 bfr[2];
#pragma unroll
            for (int n2 = 0; n2 < 2; ++n2) {
                const float* src = wg + (size_t)(32 * s + 8 * q) * 256 + 16 * (2 * wave + n2) + sub;
                f32x4 v0 = {src[0], src[256], src[512], src[768]}, v1 = {src[1024], src[1280], src[1536], src[1792]};
                bfr[n2] = pack8(v0, v1);
            }
#pragma unroll
            for (int mt = 0; mt < 4; ++mt) {
                const bf16x8 af = *(const LAS bf16x8*)(Gs + (16 * mt + sub) * 264 + 32 * s + 8 * q);
#pragma unroll
                for (int n2 = 0; n2 < 2; ++n2) z[n2][mt] = MFMA16(af, bfr[n2], z[n2][mt]);
            }
        }
        float bg[2], onw[2]; float gk[2][4][4];
#pragma unroll
        for (int n2 = 0; n2 < 2; ++n2) { const int n = 16 * (2 * wave + n2) + sub; bg[n2] = p.in_(I_BGLU)[layer * 256 + n]; onw[n2] = p.in_(I_ON)[layer * DM + 512 + n]; }
#pragma unroll
        for (int mt = 0; mt < 4; ++mt)
#pragma unroll
            for (int r = 0; r < 4; ++r) {
                float ss = 0.f;
#pragma unroll
                for (int n2 = 0; n2 < 2; ++n2) { const float gg = bf2f(Gs[(16 * mt + 4 * q + r) * 264 + 16 * (2 * wave + n2) + sub]); const float o = gg * sigm(z[n2][mt][r] + bg[n2]); gk[n2][mt][r] = o; ss += o * o; }
                ss = sum16(ss);
                if (sub == 0) rowss[wave * 64 + 16 * mt + 4 * q + r] = ss;
            }
        __syncthreads();
        bf16_t* O = (bf16_t*)(p.ws + W_O);
#pragma unroll
        for (int mt = 0; mt < 4; ++mt)
#pragma unroll
            for (int r = 0; r < 4; ++r) {
                const int t = 16 * mt + 4 * q + r;
                float rs = 0.f;
#pragma unroll
                for (int w8 = 0; w8 < 8; ++w8) rs += rowss[w8 * 64 + t];
                const float rinv = rsqrtf(rs * (1.f / 256.f) + EPS);
#pragma unroll
                for (int n2 = 0; n2 < 2; ++n2) O[(size_t)(row0 + t) * DM + 512 + 16 * (2 * wave + n2) + sub] = f2bf(gk[n2][mt][r] * rinv * onw[n2]);
            }
    }
    __syncthreads();
}

template <bool SAMPLE, bool PASS2>
DI void lru_item(const PV& p, int layer, int item, LAS unsigned char* lds) {
    const int tid = p.tid, wave = tid >> 6, lane = tid & 63, sub = lane & 15, q = lane >> 4;
    int row0, b = 0, c = 0;
    if (SAMPLE) row0 = NP + item * 64; else { b = item >> 6; c = item & 63; row0 = b * 4096 + c * 64; }
    const float* XR = (const float*)(p.ws + W_XR); const float* YG = (const float*)(p.ws + W_YG);
    float* LAG = (float*)(p.ws + W_LAG);
    LAS float* XcF = (LAS float*)lds;
    LAS bf16_t* XcB = (LAS bf16_t*)(XcF + 64 * 256);
    LAS float* rowss = (LAS float*)(XcB + 64 * 264);
    const float* cw = p.in_(I_LCW) + layer * 4 * 256; const float* cb = p.in_(I_LCB) + layer * 256;
#pragma unroll 4
    for (int i = tid; i < 64 * 256; i += 512) {
        const int t = i >> 8, ch = i & 255, row = row0 + t;
        float acc = cb[ch];
#pragma unroll
        for (int j = 0; j < 4; ++j) {
            float v;
            if (SAMPLE) {
                const int ts = row & 3, idx = ts + j, sq = (row - NP) >> 2;
                v = idx < 3 ? p.in_(I_SLC)[((size_t)(layer * 128 + sq) * 3 + idx) * 256 + ch] : XR[(size_t)(row - ts + idx - 3) * 256 + ch];
            } else {
                const int sidx = c * 64 + t + j - 3;
                v = sidx >= 0 ? XR[(size_t)(b * 4096 + sidx) * 256 + ch] : 0.f;
            }
            acc += cw[j * 256 + ch] * v;
        }
        XcF[i] = acc; XcB[t * 264 + ch] = f2bf(acc);
    }
    if (PASS2) { if (tid < 64) rowss[tid] = 0.f; }
    __syncthreads();
    const int blk = wave >> 1;
    bf16x8 Bfa[2][2], Bfi[2][2];
    float ba[2], bi[2], sp[2], hin[2], aagg[2], onw[2];
    float ok[2][4][4];
#pragma unroll
    for (int ci = 0; ci < 2; ++ci) {
        const int ch = 32 * wave + 16 * ci + sub, jc = ch - 64 * blk;
#pragma unroll
        for (int s = 0; s < 2; ++s) {
            const float* sa = p.in_(I_LWA) + ((size_t)(layer * 4 + blk) * 64 + 32 * s + 8 * q) * 64 + jc;
            const float* si = p.in_(I_LWI) + ((size_t)(layer * 4 + blk) * 64 + 32 * s + 8 * q) * 64 + jc;
            Bfa[ci][s] = pack8((f32x4){sa[0], sa[64], sa[128], sa[192]}, (f32x4){sa[256], sa[320], sa[384], sa[448]});
            Bfi[ci][s] = pack8((f32x4){si[0], si[64], si[128], si[192]}, (f32x4){si[256], si[320], si[384], si[448]});
        }
        ba[ci] = p.in_(I_LBA)[layer * 256 + ch]; bi[ci] = p.in_(I_LBI)[layer * 256 + ch];
        sp[ci] = log1pf(expf(-p.in_(I_LAM)[layer * 256 + ch]));
        onw[ci] = p.in_(I_ON)[layer * DM + 768 + ch];
        hin[ci] = 0.f; aagg[ci] = 1.f;
        if (PASS2 && !SAMPLE) {
            float h = 0.f;
#pragma unroll 1
            for (int j0 = 0; j0 < c; j0 += 8) {
                float la[8], ls[8];
#pragma unroll
                for (int u = 0; u < 8; ++u) { const int jj = (j0 + u < c) ? j0 + u : c - 1; la[u] = LAG[((size_t)(b * 64 + jj) * 2 + 0) * 256 + ch]; ls[u] = LAG[((size_t)(b * 64 + jj) * 2 + 1) * 256 + ch]; }
#pragma unroll
                for (int u = 0; u < 8; ++u) if (j0 + u < c) h = la[u] * h + ls[u];
            }
            hin[ci] = h;
        }
    }
#pragma unroll
    for (int tt = 0; tt < 4; ++tt) {
        bf16x8 Af[2];
#pragma unroll
        for (int s = 0; s < 2; ++s) Af[s] = *(const LAS bf16x8*)(XcB + (16 * tt + sub) * 264 + 64 * blk + 32 * s + 8 * q);
#pragma unroll
        for (int ci = 0; ci < 2; ++ci) {
            const int ch = 32 * wave + 16 * ci + sub;
            f32x4 Ra = {0.f, 0.f, 0.f, 0.f}, Ri = Ra;
#pragma unroll
            for (int s = 0; s < 2; ++s) { Ra = MFMA16(Af[s], Bfa[ci][s], Ra); Ri = MFMA16(Af[s], Bfi[ci][s], Ri); }
            float av[4], bv[4];
#pragma unroll
            for (int r = 0; r < 4; ++r) {
                const int t = 16 * tt + 4 * q + r;
                const float xc = XcF[t * 256 + ch];
                const float rg = sigm(Ra[r] + ba[ci]), ig = sigm(Ri[r] + bi[ci]);
                const float la = -8.f * rg * sp[ci];
                av[r] = __expf(la);
                float mult = sqrtf(-expm1f(2.f * la));
                if (!SAMPLE && c == 0 && t == 0) mult = 1.f;
                bv[r] = mult * ig * xc;
            }
            float in;
            if (SAMPLE) {
                const int sq = (row0 - NP) / 4 + 4 * tt + q;
                in = p.in_(I_SLH)[(size_t)(layer * 128 + sq) * 256 + ch];
            } else {
                float x = bv[0]; x = av[1] * x + bv[1]; x = av[2] * x + bv[2]; x = av[3] * x + bv[3];
                const float P = av[0] * av[1] * av[2] * av[3];
                float e[4], Pk[4];
#pragma unroll
                for (int k = 0; k < 4; ++k) { e[k] = __shfl(x, sub + 16 * k); Pk[k] = __shfl(P, sub + 16 * k); }
                const float E0 = Pk[0] * hin[ci] + e[0], E1 = Pk[1] * E0 + e[1], E2 = Pk[2] * E1 + e[2], E3 = Pk[3] * E2 + e[3];
                in = q == 0 ? hin[ci] : (q == 1 ? E0 : (q == 2 ? E1 : E2));
                hin[ci] = E3; aagg[ci] *= Pk[0] * Pk[1] * Pk[2] * Pk[3];
            }
            if (PASS2) {
                float h = in;
#pragma unroll
                for (int r = 0; r < 4; ++r) {
                    const int t = 16 * tt + 4 * q + r;
                    h = av[r] * h + bv[r];
                    ok[ci][tt][r] = h * gelu_t(YG[(size_t)(row0 + t) * 256 + ch]);
                }
                if (SAMPLE) { const int sq = (row0 - NP) / 4 + 4 * tt + q; p.out[O_SLH + (size_t)(layer * 128 + sq) * 256 + ch] = h; }
            }
        }
        if (PASS2) {
#pragma unroll
            for (int r = 0; r < 4; ++r) {
                float ss = ok[0][tt][r] * ok[0][tt][r] + ok[1][tt][r] * ok[1][tt][r];
                ss = sum16(ss);
                if (sub == 0) rowss[wave * 64 + 16 * tt + 4 * q + r] = ss;
            }
        }
    }
    if (!SAMPLE && q == 0) {
#pragma unroll
        for (int ci = 0; ci < 2; ++ci) {
            const int ch = 32 * wave + 16 * ci + sub;
            if (!PASS2) { LAG[((size_t)(b * 64 + c) * 2 + 0) * 256 + ch] = aagg[ci]; LAG[((size_t)(b * 64 + c) * 2 + 1) * 256 + ch] = hin[ci]; }
            else if (c == 63) p.out[O_PLH + (size_t)(layer * 4 + b) * 256 + ch] = hin[ci];
        }
    }
    if (PASS2) {
        __syncthreads();
        bf16_t* O = (bf16_t*)(p.ws + W_O);
#pragma unroll
        for (int tt = 0; tt < 4; ++tt)
#pragma unroll
            for (int r = 0; r < 4; ++r) {
                const int t = 16 * tt + 4 * q + r;
                float rs = 0.f;
#pragma unroll
                for (int w8 = 0; w8 < 8; ++w8) rs += rowss[w8 * 64 + t];
                const float rinv = rsqrtf(rs * (1.f / 256.f) + EPS);
#pragma unroll
                for (int ci = 0; ci < 2; ++ci) O[(size_t)(row0 + t) * DM + 768 + 32 * wave + 16 * ci + sub] = f2bf(ok[ci][tt][r] * rinv * onw[ci]);
            }
    }
    __syncthreads();
}

DI void l2_evict(const float* wup0, unsigned char* ws0, int wv0) {
    const int tid = wv0 * 64 + (int)__builtin_amdgcn_mbcnt_hi(~0u, __builtin_amdgcn_mbcnt_lo(~0u, 0u));
    const u32x4* src = (const u32x4*)wup0 + (size_t)blockIdx.x * (EVICT_KB * 64);
    u32x4 a = {0u, 0u, 0u, 0u};
#pragma unroll 1
    for (int i = tid; i < EVICT_KB * 64; i += 2048) { const u32x4 v0 = src[i], v1 = src[i + 512], v2 = src[i + 1024], v3 = src[i + 1536]; a.x ^= v0.x ^ v1.x ^ v2.x ^ v3.x; a.y ^= v0.y ^ v1.y ^ v2.y ^ v3.y; a.z ^= v0.z ^ v1.z ^ v2.z ^ v3.z; a.w ^= v0.w ^ v1.w ^ v2.w ^ v3.w; }
    if ((a.x ^ a.y ^ a.z ^ a.w) == 0x9e3779b9u && a.x == 0x12345u) ws0[W_END - 1] = 1;
}
#define GSYNC() do { if (P.ph_hi - P.ph_lo <= 1) break; grid.sync(); } while (0)
#define MAKE_PV() \
    unsigned _wl = (unsigned)(unsigned long long)P.ws, _wh = (unsigned)((unsigned long long)P.ws >> 32), _ol = (unsigned)(unsigned long long)P.out, _oh = (unsigned)((unsigned long long)P.out >> 32); \
    int z = 0, bidx = blockIdx.x, nbx = gridDim.x; \
    asm volatile("" : "+v"(_wl), "+v"(_wh), "+v"(_ol), "+v"(_oh), "+v"(z), "+v"(bidx), "+v"(nbx)); \
    _wl = __builtin_amdgcn_readfirstlane(_wl); _wh = __builtin_amdgcn_readfirstlane(_wh); _ol = __builtin_amdgcn_readfirstlane(_ol); _oh = __builtin_amdgcn_readfirstlane(_oh); \
    z = __builtin_amdgcn_readfirstlane(z); bidx = __builtin_amdgcn_readfirstlane(bidx); nbx = __builtin_amdgcn_readfirstlane(nbx); \
    unsigned char* ws = (unsigned char*)(((unsigned long long)_wh << 32) | _wl); float* outp = (float*)(((unsigned long long)_oh << 32) | _ol); \
    int tidx = wv0 * 64 + (int)__builtin_amdgcn_mbcnt_hi(~0u, __builtin_amdgcn_mbcnt_lo(~0u, 0u)); asm volatile("" : "+v"(tidx)); \
    const PV p{P, z, outp, ws, tidx, bidx, nbx}; \
    float* X = outp + O_YP; float* MOD = (float*)(ws + W_MOD); (void)X; (void)MOD;

template <int l>
DI void layer_phases(const Params& P, LAS unsigned char* lds, cg::grid_group& grid, const int wv0, const float* wup0, unsigned char* ws0) {
    {   MAKE_PV();
        constexpr int le = l;
        const float* xp = le == 0 ? p.in_(I_XP) : X; const float* xs_adj = le == 0 ? p.in_(I_XS) - (size_t)NP * DM : X;
        if (EN(0) && ORD(2 + 9 * l + 0)) phase_norm(p, xp, xs_adj, p.in_(I_NORM1) + le * DM, MOD + le * NMOD, (bf16_t*)(ws + W_H));
    }
    GSYNC();
    {   MAKE_PV();
        EpiIn E; E.layer = l; E.Q = (bf16_t*)(ws + W_Q); E.Kb = (bf16_t*)(ws + W_KB); E.Vb = (bf16_t*)(ws + W_VB);
        E.U = (float*)(ws + W_U); E.XR = (float*)(ws + W_XR); E.YG = (float*)(ws + W_YG);
        E.qn = p.in_(I_QN); E.kn = p.in_(I_KN); E.rotc = (const float*)(ws + W_ROTC); E.rots = (const float*)(ws + W_ROTS); E.out = outp;
        if (EN(1) && ORD(2 + 9 * l + 1)) run_gemm(p, lds, (const bf16_t*)(ws + W_H), (const bf16_t*)(ws + W_WTIN) + (size_t)l * DIN * DM, NTOK, DIN, DM, E);
    }
    GSYNC();
    {   int bid0 = blockIdx.x, nb0 = gridDim.x; asm volatile("" : "+v"(bid0), "+v"(nb0)); bid0 = __builtin_amdgcn_readfirstlane(bid0); nb0 = __builtin_amdgcn_readfirstlane(nb0);
#pragma unroll 1
        for (int it = bid0; it < 2048 + 768; it += nb0) {
            MAKE_PV();
            if (it < 2048) { if (EN(20) && ORD(2 + 9 * l + 2)) attn_prompt16_item(p, l, it, lds); }
            else if (it < 2048 + 256) { if (EN(21) && ORD(2 + 9 * l + 2)) attn_sample_item(p, l, it - 2048, lds); }
            else if (it < 2048 + 512) { if (EN(22) && ORD(2 + 9 * l + 2) && ((it - 2048 - 256) & 63) != 63) ssm_item<false, false>(p, l, it - 2048 - 256, lds); }
            else { if (EN(23) && ORD(2 + 9 * l + 2) && ((it - 2048 - 512) & 63) != 63) lru_item<false, false>(p, l, it - 2048 - 512, lds); }
        }
    }
    GSYNC();
    {   int bid0 = blockIdx.x, nb0 = gridDim.x; asm volatile("" : "+v"(bid0), "+v"(nb0)); bid0 = __builtin_amdgcn_readfirstlane(bid0); nb0 = __builtin_amdgcn_readfirstlane(nb0);
#pragma unroll 1
        for (int it = bid0; it < 594; it += nb0) {
            MAKE_PV();
            if (it < 256) { if (EN(30) && ORD(2 + 9 * l + 3)) ssm_item<false, true>(p, l, it, lds); }
            else if (it < 512) { if (EN(31) && ORD(2 + 9 * l + 3)) lru_item<false, true>(p, l, it - 256, lds); }
            else if (it < 520) { if (EN(32) && ORD(2 + 9 * l + 3)) ssm_item<true, true>(p, l, it - 512, lds); }
            else if (it < 528) { if (EN(33) && ORD(2 + 9 * l + 3)) lru_item<true, true>(p, l, it - 520, lds); }
            else { if (EN(34) && ORD(2 + 9 * l + 3)) attn_norm_item(p, l, it - 528); }
        }
    }
    GSYNC();
    {   MAKE_PV();
        const float* xp = l == 0 ? p.in_(I_XP) : X; const float* xs_adj = l == 0 ? p.in_(I_XS) - (size_t)NP * DM : X;
        EpiRes E; E.xp = xp; E.xs_adj = xs_adj; E.X = X; E.MODg = MOD + l * NMOD + 2048;
        if (EN(4) && ORD(2 + 9 * l + 4)) run_gemm(p, lds, (const bf16_t*)(ws + W_O), (const bf16_t*)(ws + W_WTO) + (size_t)l * DM * DM, NTOK, DM, DM, E);
    }
    GSYNC();
    {   MAKE_PV();
        if (EN(5) && ORD(2 + 9 * l + 5)) phase_norm(p, X, X, p.in_(I_NORM2) + l * DM, MOD + l * NMOD + 3072, (bf16_t*)(ws + W_H2));
    }
    GSYNC();
    {   MAKE_PV();
        EpiUp E; E.layer = l; E.UP = (bf16_t*)(ws + W_UP); E.out = outp;
        if (EN(6) && ORD(2 + 9 * l + 6)) run_gemm(p, lds, (const bf16_t*)(ws + W_H2), (const bf16_t*)(ws + W_WTUP) + (size_t)l * DUP * DM, NTOK, DUP, DM, E);
    }
    GSYNC();
    {   MAKE_PV();
        if (EN(7) && ORD(2 + 9 * l + 7)) phase_convglu(p, l);
    }
    GSYNC();
    {   MAKE_PV();
        EpiRes E; E.xp = X; E.xs_adj = X; E.X = X; E.MODg = MOD + l * NMOD + 5120;
        if (EN(8) && ORD(2 + 9 * l + 8)) run_gemm(p, lds, (const bf16_t*)(ws + W_ACT), (const bf16_t*)(ws + W_WTDN) + (size_t)l * DM * DFF, NTOK, DM, DFF, E);
    }
}

__global__ void __launch_bounds__(512) hymba_mega(Params P) {
    extern __shared__ __attribute__((aligned(16))) unsigned char shm[];
    LAS unsigned char* lds = (LAS unsigned char*)shm;
    cg::grid_group grid = cg::this_grid();
    const int wv0 = __builtin_amdgcn_readfirstlane((int)(threadIdx.x >> 6));
    const float* wup0 = P.in[I_WUP]; unsigned char* ws0 = P.ws;
    {   MAKE_PV();
        if (EN(100) && ORD(0)) phase_prologue(p, lds);
    }
    GSYNC();
    {   MAKE_PV();
        EpiAda E; E.MOD = MOD; E.bias = p.in_(I_BADA);
        if (EN(101) && ORD(1)) run_gemm(p, lds, (const bf16_t*)(ws + W_CSILU), (const bf16_t*)(ws + W_WTADA), 256, NMODALL, DM, E);
    }
    GSYNC();
    layer_phases<0>(P, lds, grid, wv0, wup0, ws0);
    GSYNC();
    layer_phases<1>(P, lds, grid, wv0, wup0, ws0);
    GSYNC();
    layer_phases<2>(P, lds, grid, wv0, wup0, ws0);
    GSYNC();
    layer_phases<3>(P, lds, grid, wv0, wup0, ws0);
#ifdef STALE_TEST
    {
        float* T = (float*)(P.ws + W_UP); unsigned* cnt = (unsigned*)(P.ws + W_ACT);
        const int tid = wv0 * 64 + (int)__builtin_amdgcn_mbcnt_hi(~0u, __builtin_amdgcn_mbcnt_lo(~0u, 0u));
        const size_t n = (size_t)16 * 1024 * 1024, per = n / gridDim.x;
        if (blockIdx.x == 0 && tid < 8) cnt[tid] = 0u;
        for (int rep = 0; rep < 4; ++rep) {
            const float val = (float)(rep + 1);
            for (size_t i = (size_t)blockIdx.x * per + tid; i < (size_t)(blockIdx.x + 1) * per; i += 512) T[i] = val;
            GSYNC();
            const int rb = (blockIdx.x + 3 + rep) % gridDim.x; unsigned bad = 0;
            for (size_t i = (size_t)rb * per + tid; i < (size_t)(rb + 1) * per; i += 512) bad += (T[i] != val) ? 1u : 0u;
            if (bad) atomicAdd(cnt + rep, bad);
            GSYNC();
        }
        float* X = P.out + O_YP;
        for (size_t i = (size_t)blockIdx.x * 512 + tid; i < (size_t)NTOK * DM; i += (size_t)gridDim.x * 512) X[i] = (i < 4) ? 1000.f + (float)cnt[i] : 0.f;
    }
#endif
#ifdef DIAG2
    if (ORD(40)) {   MAKE_PV();
        const u32x4* src = (const u32x4*)(ws + DIAG_OFF); u32x4* dst = (u32x4*)(ws + W_ACT);
        for (size_t i = (size_t)bidx * 512 + tidx; i < (size_t)DIAG_BYTES / 16; i += (size_t)nbx * 512) dst[i] = src[i];
        if (bidx == 0 && tidx == 0) *(unsigned*)(ws + W_ACT + 64 * 1024 * 1024) = 0u;
    }
    if (ORD(41)) {   MAKE_PV();
        const bf16_t* a = (const bf16_t*)(ws + DIAG_OFF); const bf16_t* b = (const bf16_t*)(ws + W_ACT); float mx = 0.f;
        for (size_t i = (size_t)bidx * 512 + tidx; i < (size_t)DIAG_BYTES / 2; i += (size_t)nbx * 512) mx = fmaxf(mx, fabsf(bf2f(a[i]) - bf2f(b[i])));
        atomicMax((unsigned*)(ws + W_ACT + 64 * 1024 * 1024), __float_as_uint(mx));
    }
    if (ORD(42)) {   MAKE_PV();
        const float mx = __uint_as_float(*(const unsigned*)(ws + W_ACT + 64 * 1024 * 1024));
        for (size_t i = (size_t)bidx * 512 + tidx; i < (size_t)NTOK * DM; i += (size_t)nbx * 512) X[i] = (i == 0) ? 1000.f + 1.0e6f * mx : 0.f;
    }
#endif
#ifdef DUMP_OFF
    GSYNC();
    if (ORD(38)) {   MAKE_PV();
        const bf16_t* Qd = (const bf16_t*)(ws + W_Q); const bf16_t* Kd = (const bf16_t*)(ws + W_KB); const bf16_t* Vd = (const bf16_t*)(ws + W_VB);
        const float* OA = (const float*)(ws + W_OATT);
        for (size_t i = (size_t)bidx * 512 + tidx; i < (size_t)NTOK * DM; i += (size_t)nbx * 512) {
            const int c = (int)(i & 1023); const size_t row = i >> 10; float v = 0.f;
            if (DUMP_MODE == 3) { { if (c < 512) v = 4096.f * bf2f(Qd[row * 512 + c]); else if (c < 640) v = 512.f * bf2f(Kd[row * 128 + c - 512]); else if (c < 768) v = 512.f * bf2f(Vd[row * 128 + c - 640]); } }
            if (DUMP_MODE == 8) { v = 4096.f * X[i]; }
            if (DUMP_MODE == 2) { if (c < 512 && row < NP) v = 4096.f * OA[row * 512 + c]; }
            if (DUMP_MODE == 7) { const float* Ud = (const float*)(ws + W_U); const float* XRd = (const float*)(ws + W_XR); const float* YGd = (const float*)(ws + W_YG); if (c < 256) v = 4096.f * Ud[row * 256 + c]; else if (c < 512) v = 4096.f * XRd[row * 256 + c - 256]; else if (c < 768) v = 4096.f * YGd[row * 256 + c - 512]; }
            if (DUMP_MODE == 9) { const bf16_t* Od = (const bf16_t*)(ws + W_O); v = 256.f * bf2f(Od[i]); }
            if (DUMP_MODE == 6) { const bf16_t* Hd = (const bf16_t*)(ws + W_H); v = 64.f * bf2f(Hd[i]); }
            if (DUMP_MODE == 5) { const bf16_t* Wd = (const bf16_t*)(ws + W_WTIN); if (i < (size_t)4 * DIN * DM + (size_t)4 * DM * DM) v = 256.f * bf2f(Wd[i]); }
            X[i] = v; }
    }
#endif
}

constexpr int N_PHASES = 2 + 9 * DEPTH;

extern "C" void kernel_launch(void* const* d_in, const int* in_sizes, int n_in, void* d_out, int out_size, void* d_ws, size_t ws_size, hipStream_t stream) {
    static int grid = 0;
    if (grid == 0) {
        if (n_in != N_IN || (size_t)out_size != O_END || ws_size < W_END) {
            fprintf(stderr, "kernel_launch: unexpected sizes n_in %d out %d ws %zu (need %zu)\n", n_in, out_size, ws_size, (size_t)W_END); grid = -1; return; }
        int dev = 0, cus = 0, per_cu = 0;
        (void)hipGetDevice(&dev);
        (void)hipDeviceGetAttribute(&cus, hipDeviceAttributeMultiprocessorCount, dev);
        if (hipFuncSetAttribute((const void*)hymba_mega, hipFuncAttributeMaxDynamicSharedMemorySize, LDS_BYTES) != hipSuccess) { fprintf(stderr, "kernel_launch: hipFuncSetAttribute failed\n"); grid = -1; return; }
        if (hipOccupancyMaxActiveBlocksPerMultiprocessor(&per_cu, (const void*)hymba_mega, 512, LDS_BYTES) != hipSuccess || per_cu < 1) { fprintf(stderr, "kernel_launch: occupancy query failed (%d)\n", per_cu); (void)hipGetLastError(); per_cu = 1; }
        grid = cus * per_cu;
    }
    if (grid < 0) return;
    Params p{};
    for (int i = 0; i < N_IN; ++i) p.in[i] = (const float*)d_in[i];
    p.out = (float*)d_out; p.ws = (unsigned char*)d_ws;
#if MULTI_LAUNCH
    const int olist[] = {0, 1, 2, 40, 2, 41, 42};
    for (int oi = 0; oi < (int)(sizeof(olist) / sizeof(int)); ++oi) {
        const int o = olist[oi];
        p.ph_lo = o; p.ph_hi = o + 1;
        hipLaunchKernelGGL(hymba_mega, dim3(grid), dim3(512), LDS_BYTES, stream, p);
    }
#else
    p.ph_lo = 0; p.ph_hi = N_PHASES;
    void* args[] = {&p};
    hipError_t e = hipLaunchCooperativeKernel((const void*)hymba_mega, dim3(grid), dim3(512), args, LDS_BYTES, stream);
    if (e != hipSuccess) fprintf(stderr, "cooperative launch failed: %s (grid %d)\n", hipGetErrorString(e), grid);
#endif
}
```

```cpp
#include <hip/hip_runtime.h>
#include <hip/hip_cooperative_groups.h>
#include <cstdio>
namespace cg = cooperative_groups;

typedef unsigned short bf16_t;
typedef short bf16x8 __attribute__((ext_vector_type(8)));
typedef float f32x4 __attribute__((ext_vector_type(4)));
typedef unsigned u32x4 __attribute__((ext_vector_type(4)));
typedef unsigned u32x2 __attribute__((ext_vector_type(2)));
#define LAS __attribute__((address_space(3)))
#define DI __device__ __forceinline__

constexpr int DM = 1024, NP = 16384, NS = 512, NTOK = NP + NS, NSEQ = 132, DEPTH = 4;
constexpr int DIN = 1536, DFF = 2816, DUP = 5632, NMOD = 6144, NMODALL = 4 * NMOD;
constexpr float EPS = 1e-6f;

enum { I_XP = 0, I_XS, I_CK, I_CV, I_SRE, I_SIM, I_SLH, I_SLC, I_SFC, I_CP, I_CS, I_WADA, I_BADA, I_NORM1, I_WIN, I_QN, I_KN, I_SINK,
       I_ARE, I_AIM, I_BRE, I_BIM, I_CRE, I_CIM, I_SD, I_LDT, I_WGLU, I_BGLU, I_LCW, I_LCB, I_LWA, I_LBA, I_LWI, I_LBI, I_LAM, I_ON,
       I_WO, I_NORM2, I_WUP, I_FCW, I_FCB, I_WDN, N_IN };

constexpr size_t O_YP = 0;
constexpr size_t O_YS = O_YP + (size_t)NP * DM;
constexpr size_t O_PK = O_YS + (size_t)NS * DM;
constexpr size_t O_PV = O_PK + (size_t)4 * 4 * 128 * 128;
constexpr size_t O_PRE = O_PV + (size_t)4 * 4 * 128 * 128;
constexpr size_t O_PIM = O_PRE + (size_t)4 * 4 * 1024;
constexpr size_t O_PLH = O_PIM + (size_t)4 * 4 * 1024;
constexpr size_t O_PLC = O_PLH + (size_t)4 * 4 * 256;
constexpr size_t O_PFC = O_PLC + (size_t)4 * 4 * 3 * 256;
constexpr size_t O_SK = O_PFC + (size_t)4 * 4 * 2 * DUP;
constexpr size_t O_SV = O_SK + (size_t)4 * 128 * 128 * 128;
constexpr size_t O_SRE = O_SV + (size_t)4 * 128 * 128 * 128;
constexpr size_t O_SIM = O_SRE + (size_t)4 * 128 * 1024;
constexpr size_t O_SLH = O_SIM + (size_t)4 * 128 * 1024;
constexpr size_t O_SLC = O_SLH + (size_t)4 * 128 * 256;
constexpr size_t O_SFC = O_SLC + (size_t)4 * 128 * 3 * 256;
constexpr size_t O_END = O_SFC + (size_t)4 * 128 * 2 * DUP;

constexpr size_t al256(size_t x) { return (x + 255) & ~(size_t)255; }
constexpr size_t W_WTIN = 0;
constexpr size_t W_WTO = al256(W_WTIN + (size_t)4 * DIN * DM * 2);
constexpr size_t W_WTUP = al256(W_WTO + (size_t)4 * DM * DM * 2);
constexpr size_t W_WTDN = al256(W_WTUP + (size_t)4 * DUP * DM * 2);
constexpr size_t W_MOD = al256(W_WTDN + (size_t)4 * DM * DFF * 2);
constexpr size_t W_ROTC = al256(W_MOD + (size_t)NSEQ * NMODALL * 4);
constexpr size_t W_ROTS = al256(W_ROTC + (size_t)4100 * 32 * 4);
constexpr size_t W_ABAR = al256(W_ROTS + (size_t)4100 * 32 * 4);
constexpr size_t W_BB = al256(W_ABAR + (size_t)4 * 16 * 64 * 2 * 4);
constexpr size_t W_SST = al256(W_BB + (size_t)4 * 16 * 2 * 64 * 16 * 4);
constexpr size_t W_LAG = al256(W_SST + (size_t)4 * 64 * 16 * 64 * 2 * 4);
constexpr size_t W_H2 = al256(W_LAG + (size_t)4 * 64 * 2 * 256 * 4);
constexpr size_t W_R1 = al256(W_H2 + (size_t)NTOK * DM * 2);
constexpr size_t W_UP = W_R1;
constexpr size_t W_H = W_R1;
constexpr size_t W_Q = al256(W_H + (size_t)NTOK * DM * 2);
constexpr size_t W_KB = al256(W_Q + (size_t)NTOK * 512 * 2);
constexpr size_t W_VB = al256(W_KB + (size_t)NTOK * 128 * 2);
constexpr size_t W_U = al256(W_VB + (size_t)NTOK * 128 * 2);
constexpr size_t W_XR = al256(W_U + (size_t)NTOK * 256 * 4);
constexpr size_t W_YG = al256(W_XR + (size_t)NTOK * 256 * 4);
constexpr size_t W_OATT = al256(W_YG + (size_t)NTOK * 256 * 4);
constexpr size_t W_O = al256(W_OATT + (size_t)NTOK * 512 * 4);
constexpr size_t W_R1END = al256(W_O + (size_t)NTOK * DM * 2);
constexpr size_t W_R2 = al256(W_R1 + (size_t)NTOK * DUP * 2);
constexpr size_t W_ACT = W_R2;
constexpr size_t W_WTADA = W_R2;
constexpr size_t W_CSILU = al256(W_WTADA + (size_t)NMODALL * DM * 2);
constexpr size_t W_R2A = al256(W_CSILU + (size_t)256 * DM * 2);
constexpr size_t W_R2B = al256(W_R2 + (size_t)NTOK * DFF * 2);
constexpr size_t W_END = (W_R2A > W_R2B ? W_R2A : W_R2B);
static_assert(W_R1END <= W_R2, "mixer buffers must fit in the UP region");

constexpr int LDS_BYTES = 131072;
#ifndef ONLY_PH
#define ONLY_PH -1
#endif
#define EN(k) (ONLY_PH < 0 || ONLY_PH == (k))
#ifndef MAX_ORD
#define MAX_ORD 1000
#define MULTI_LAUNCH 0
#define SIMPLE_GEMM 0
#define EVICT_KB 352
#endif
#define ORD(o) ((o) >= P.ph_lo && (o) < P.ph_hi && ((o) <= (MAX_ORD) || (o) >= 38))

struct Params {
    const float* in[N_IN];
    float* out;
    unsigned char* ws;
    int ph_lo, ph_hi;
};

struct PV {
    const Params& P; int z; float* out; unsigned char* ws; int tid, bid, nb;
    __device__ __forceinline__ const float* in_(int i) const { return P.in[i + z]; }
};

DI unsigned cvt_pk_bf16(float lo, float hi) { unsigned r; asm volatile("v_cvt_pk_bf16_f32 %0, %1, %2" : "=v"(r) : "v"(lo), "v"(hi)); return r; }
DI bf16_t f2bf(float f) { return (bf16_t)(cvt_pk_bf16(f, 0.f) & 0xffffu); }
DI float bf2f(bf16_t b) { return __uint_as_float(((unsigned)b) << 16); }
DI float gelu_t(float x) { const float u = 1.5957691216f * (x + 0.044715f * x * x * x); return x / (1.f + __expf(-u)); }
DI float sigm(float x) { return 1.f / (1.f + __expf(-x)); }
DI int seq_of(int row) { return row < NP ? (row >> 12) : 4 + ((row - NP) >> 2); }
DI bf16x8 pack8(f32x4 a, f32x4 b) {
    u32x4 r; r.x = cvt_pk_bf16(a.x, a.y); r.y = cvt_pk_bf16(a.z, a.w); r.z = cvt_pk_bf16(b.x, b.y); r.w = cvt_pk_bf16(b.z, b.w);
    return __builtin_bit_cast(bf16x8, r);
}
DI float wave_sum(float v) {
#pragma unroll
    for (int o = 1; o < 64; o <<= 1) v += __shfl_xor(v, o);
    return v;
}
DI float sum16(float v) {
#pragma unroll
    for (int o = 1; o < 16; o <<= 1) v += __shfl_xor(v, o);
    return v;
}
DI float max16(float v) {
#pragma unroll
    for (int o = 1; o < 16; o <<= 1) v = fmaxf(v, __shfl_xor(v, o));
    return v;
}
#define MFMA16(a, b, c) __builtin_amdgcn_mfma_f32_16x16x32_bf16((a), (b), (c), 0, 0, 0)

#ifndef GLDS_AUX
#define GLDS_AUX 0
#endif
namespace pg8 {
constexpr int BM = 256, BK = 64, HALF = 128, HTB = HALF * BK * 2, STAGE_BYTES = 8 * HTB, NXCD = 8, WGM = 8;
DI int lds_byte(int r, int c) { const int st = (r >> 4) * 2 + (c >> 5), rr = r & 15, cc = c & 31, ob = rr * 64 + cc * 2; return st * 1024 + (ob ^ (((ob >> 9) & 1) << 5)); }
DI void stage_rc(int b, int& R, int& C) { const int st = b / 1024, sb = b % 1024, swz = sb ^ (((sb >> 9) & 1) << 5); R = (st >> 1) * 16 + swz / 64; C = (st & 1) * 32 + (swz % 64) / 2; }
struct Unit { int pm, pn; };
struct Gemm { const bf16_t* A; const bf16_t* Bt; int M, N, K; };
struct StaticOrder {
    int nM, nN, nwg, G, c;
    DI void init(int M, int N, int G_, int c_) { nM = M / BM; nN = N / BM; nwg = nM * nN; G = G_; c = c_; }
    DI bool next(int i, Unit& u) const {
        const long L = (long)i * G + c; if (L >= nwg) return false;
        int wgid = (int)L; { const int q = nwg / NXCD, r = nwg % NXCD, xcd = wgid % NXCD, off = wgid / NXCD; wgid = (xcd < r ? xcd * (q + 1) : r * (q + 1) + (xcd - r) * q) + off; }
        const int nig = WGM * nN, gid = wgid / nig, fm = gid * WGM, gsz = (nM - fm) < WGM ? (nM - fm) : WGM;
        u.pm = fm + ((wgid % nig) % gsz); u.pn = (wgid % nig) / gsz; return true;
    }
};
template <class Epi>
DI void gemm_phase(const PV& p, LAS unsigned char* lds, const Gemm g, const StaticOrder& S, const Epi& E) {
    const int tid = p.tid, wid = __builtin_amdgcn_readfirstlane(tid >> 6), lane = tid & 63, wr = wid >> 2, wc = wid & 3, fr = lane & 15, fq = lane >> 4;
    const int K = g.K, nt = K / BK;
    unsigned voffA[2];
#pragma unroll
    for (int i = 0; i < 2; ++i) { int R, C; stage_rc(tid * 16 + i * 8192, R, C); voffA[i] = (unsigned)(R * K + C) * 2u; }
    const size_t kstep = (size_t)(BK * 2);
    const size_t hstep = (size_t)HALF * K * 2;
    const size_t tstep = 2 * hstep;
    const unsigned ldsw = (unsigned)wid * 1024u;
    const int aoff = lds_byte(wr * 64 + fr, fq * 8), boff = lds_byte(wc * 32 + fr, fq * 8);
#define PG8_SA(b, h) (((b) * 2 + (h)) * HTB)
#define PG8_SB(b, h) ((4 + (b) * 2 + (h)) * HTB)
#define PG8_STAGE(bufoff, gbase) do { _Pragma("unroll") for (int _i = 0; _i < 2; ++_i) \
        __builtin_amdgcn_global_load_lds((const unsigned*)((const char*)(gbase) + voffA[_i]), (LAS unsigned*)(lds + (bufoff) + ldsw + _i * 8192), 16, 0, GLDS_AUX); } while (0)
#define PG8_LDA(dst, b, h) do { _Pragma("unroll") for (int m = 0; m < 4; ++m) _Pragma("unroll") for (int k = 0; k < 2; ++k) dst[m][k] = *(const LAS bf16x8*)(lds + PG8_SA(b, h) + aoff + m * 2048 + k * 1024); } while (0)
#define PG8_LDB(dst, b, h) do { _Pragma("unroll") for (int n = 0; n < 2; ++n) _Pragma("unroll") for (int k = 0; k < 2; ++k) dst[n][k] = *(const LAS bf16x8*)(lds + PG8_SB(b, h) + boff + n * 2048 + k * 1024); } while (0)
#define PG8_MMA(ai, bj, At, Bt) do { __builtin_amdgcn_s_setprio(1); _Pragma("unroll") for (int m = 0; m < 4; ++m) _Pragma("unroll") for (int n = 0; n < 2; ++n) _Pragma("unroll") for (int k = 0; k < 2; ++k) \
        acc[ai][bj][m][n] = __builtin_amdgcn_mfma_f32_16x16x32_bf16(Bt[n][k], At[m][k], acc[ai][bj][m][n], 0, 0, 0); __builtin_amdgcn_s_setprio(0); } while (0)
#define PG8_WAIT_V(n) asm volatile("s_waitcnt vmcnt(" #n ")" ::: "memory")
#define PG8_WAIT_L(n) asm volatile("s_waitcnt lgkmcnt(" #n ")" ::: "memory")
#define PG8_BAR __builtin_amdgcn_s_barrier()
#define PG8_SCHED __builtin_amdgcn_sched_barrier(0)
    Unit cur, nxt; int ui = 0;
    if (!S.next(0, cur)) return;
    f32x4 acc[2][2][4][2];
#pragma unroll
    for (int a = 0; a < 2; ++a)
#pragma unroll
        for (int b = 0; b < 2; ++b)
#pragma unroll
            for (int m = 0; m < 4; ++m)
#pragma unroll
                for (int n = 0; n < 2; ++n) acc[a][b][m][n] = (f32x4){0.f, 0.f, 0.f, 0.f};
    bf16x8 At[4][2], B0[2][2], B1[2][2];
    const char* cA = (const char*)g.A + (size_t)cur.pm * tstep; const char* cB = (const char*)g.Bt + (size_t)cur.pn * tstep;
    PG8_STAGE(PG8_SB(0, 0), cB); PG8_STAGE(PG8_SA(0, 0), cA); PG8_STAGE(PG8_SB(0, 1), cB + hstep); PG8_STAGE(PG8_SA(0, 1), cA + hstep);
    if (wr == 1) PG8_BAR;
    PG8_WAIT_V(4); PG8_BAR;
    PG8_STAGE(PG8_SB(1, 0), cB + kstep); PG8_STAGE(PG8_SA(1, 0), cA + kstep); PG8_STAGE(PG8_SB(1, 1), cB + hstep + kstep);
    PG8_WAIT_V(6); PG8_BAR;
    for (;;) {
        const bool has_next = S.next(ui + 1, nxt);
        const char* nA = has_next ? (const char*)g.A + (size_t)nxt.pm * tstep : cA; const char* nB = has_next ? (const char*)g.Bt + (size_t)nxt.pn * tstep : cB;
        for (int t = 0; t < nt; t += 2) {
            const bool last = (t == nt - 2);
            const char* a1 = cA + (size_t)(t + 1) * kstep;
            const char* a2 = last ? nA : cA + (size_t)(t + 2) * kstep; const char* b2 = last ? nB : cB + (size_t)(t + 2) * kstep;
            const char* a3 = a2 + kstep; const char* b3 = b2 + kstep;
            PG8_LDB(B0, 0, 0); PG8_SCHED; PG8_LDA(At, 0, 0); PG8_STAGE(PG8_SA(1, 1), a1 + hstep);
            PG8_WAIT_L(8); PG8_BAR; PG8_WAIT_L(0); PG8_MMA(0, 0, At, B0); PG8_BAR; PG8_SCHED;
            PG8_LDB(B1, 0, 1); PG8_STAGE(PG8_SB(0, 0), b2);
            PG8_BAR; PG8_WAIT_L(0); PG8_MMA(0, 1, At, B1); PG8_BAR;
            PG8_LDA(At, 0, 1); PG8_STAGE(PG8_SA(0, 0), a2);
            PG8_BAR; PG8_WAIT_L(0); PG8_MMA(1, 0, At, B0); PG8_BAR; PG8_SCHED;
            PG8_STAGE(PG8_SB(0, 1), b2 + hstep);
            PG8_WAIT_V(6); PG8_BAR; PG8_MMA(1, 1, At, B1); PG8_BAR;
            PG8_LDB(B0, 1, 0); PG8_SCHED; PG8_LDA(At, 1, 0); PG8_STAGE(PG8_SA(0, 1), a2 + hstep);
            PG8_WAIT_L(8); PG8_BAR; PG8_WAIT_L(0); PG8_MMA(0, 0, At, B0); PG8_BAR; PG8_SCHED;
            PG8_LDB(B1, 1, 1); PG8_STAGE(PG8_SB(1, 0), b3);
            PG8_BAR; PG8_WAIT_L(0); PG8_MMA(0, 1, At, B1); PG8_BAR;
            PG8_LDA(At, 1, 1); PG8_STAGE(PG8_SA(1, 0), a3);
            PG8_BAR; PG8_WAIT_L(0); PG8_MMA(1, 0, At, B0); PG8_BAR; PG8_SCHED;
            PG8_STAGE(PG8_SB(1, 1), b3 + hstep);
            PG8_WAIT_V(6); PG8_BAR; PG8_MMA(1, 1, At, B1); PG8_BAR;
        }
        E(acc, cur, wr, wc, fr, fq);
        asm volatile("s_waitcnt vmcnt(0)" ::: "memory");
        if (!has_next) break;
#pragma unroll
        for (int a = 0; a < 2; ++a)
#pragma unroll
            for (int b = 0; b < 2; ++b)
#pragma unroll
                for (int m = 0; m < 4; ++m)
#pragma unroll
                    for (int n = 0; n < 2; ++n) acc[a][b][m][n] = (f32x4){0.f, 0.f, 0.f, 0.f};
        cur = nxt; cA = nA; cB = nB; ++ui;
    }
    PG8_WAIT_V(0);
    if (wr == 0) PG8_BAR;
    PG8_BAR;
#undef PG8_SA
#undef PG8_SB
#undef PG8_STAGE
#undef PG8_LDA
#undef PG8_LDB
#undef PG8_MMA
#undef PG8_WAIT_V
#undef PG8_WAIT_L
#undef PG8_BAR
#undef PG8_SCHED
}

template <class Epi>
DI void gemm_simple(const PV& p, LAS unsigned char* lds, const Gemm g, const StaticOrder& S, const Epi& E) {
    const int tid = p.tid, wid = __builtin_amdgcn_readfirstlane(tid >> 6), lane = tid & 63, wr = wid >> 2, wc = wid & 3, fr = lane & 15, fq = lane >> 4;
    const int K = g.K, nk = K / 32;
    constexpr int RS = 80;
    constexpr int TB = 256 * RS;
    const int srow = tid >> 1, shalf = tid & 1;
    Unit cur;
    for (int ui = 0; S.next(ui, cur); ++ui) {
        f32x4 acc[2][2][4][2];
#pragma unroll
        for (int a = 0; a < 2; ++a)
#pragma unroll
            for (int b = 0; b < 2; ++b)
#pragma unroll
                for (int m = 0; m < 4; ++m)
#pragma unroll
                    for (int n = 0; n < 2; ++n) acc[a][b][m][n] = (f32x4){0.f, 0.f, 0.f, 0.f};
        const bf16_t* ga = g.A + (size_t)(cur.pm * 256 + srow) * K + shalf * 16;
        const bf16_t* gb = g.Bt + (size_t)(cur.pn * 256 + srow) * K + shalf * 16;
        u32x4 ra0 = *(const u32x4*)ga, ra1 = *(const u32x4*)(ga + 8), rb0 = *(const u32x4*)gb, rb1 = *(const u32x4*)(gb + 8);
        __syncthreads();
        {
            LAS unsigned char* wa = lds + srow * RS + shalf * 32; LAS unsigned char* wb = wa + TB;
            *(LAS u32x4*)wa = ra0; *(LAS u32x4*)(wa + 16) = ra1; *(LAS u32x4*)wb = rb0; *(LAS u32x4*)(wb + 16) = rb1;
        }
        __syncthreads();
#pragma unroll 1
        for (int t = 0; t < nk; ++t) {
            const int cb = (t & 1) * 2 * TB, nb = ((t + 1) & 1) * 2 * TB;
            if (t + 1 < nk) { ra0 = *(const u32x4*)(ga + (t + 1) * 32); ra1 = *(const u32x4*)(ga + (t + 1) * 32 + 8); rb0 = *(const u32x4*)(gb + (t + 1) * 32); rb1 = *(const u32x4*)(gb + (t + 1) * 32 + 8); }
            bf16x8 Bf[2][2];
#pragma unroll
            for (int bj = 0; bj < 2; ++bj)
#pragma unroll
                for (int n = 0; n < 2; ++n) Bf[bj][n] = *(const LAS bf16x8*)(lds + cb + TB + (bj * 128 + wc * 32 + n * 16 + fr) * RS + fq * 16);
#pragma unroll
            for (int ai = 0; ai < 2; ++ai)
#pragma unroll
                for (int m = 0; m < 4; ++m) {
                    const bf16x8 Af = *(const LAS bf16x8*)(lds + cb + (ai * 128 + wr * 64 + m * 16 + fr) * RS + fq * 16);
#pragma unroll
                    for (int bj = 0; bj < 2; ++bj)
#pragma unroll
                        for (int n = 0; n < 2; ++n) acc[ai][bj][m][n] = __builtin_amdgcn_mfma_f32_16x16x32_bf16(Bf[bj][n], Af, acc[ai][bj][m][n], 0, 0, 0);
                }
            if (t + 1 < nk) {
                LAS unsigned char* wa = lds + nb + srow * RS + shalf * 32; LAS unsigned char* wb = wa + TB;
                *(LAS u32x4*)wa = ra0; *(LAS u32x4*)(wa + 16) = ra1; *(LAS u32x4*)wb = rb0; *(LAS u32x4*)(wb + 16) = rb1;
            }
            __syncthreads();
        }
        E(acc, cur, wr, wc, fr, fq);
    }
    __syncthreads();
}
}
using pg8::Unit;
typedef f32x4 AccT[2][2][4][2];

struct EpiAda {
    float* MOD; const float* bias;
    DI void operator()(const AccT& acc, const Unit& u, int wr, int wc, int fr, int fq) const {
#pragma unroll
        for (int ai = 0; ai < 2; ++ai)
#pragma unroll
            for (int m = 0; m < 4; ++m) {
                const int r = u.pm * 256 + ai * 128 + wr * 64 + m * 16 + fr;
                if (r < NSEQ) {
#pragma unroll
                    for (int bj = 0; bj < 2; ++bj)
#pragma unroll
                        for (int n = 0; n < 2; ++n) {
                            const int col = u.pn * 256 + bj * 128 + wc * 32 + n * 16 + 4 * fq;
                            *(f32x4*)(MOD + (size_t)r * NMODALL + col) = acc[ai][bj][m][n] + *(const f32x4*)(bias + col);
                        }
                }
            }
    }
};

struct EpiIn {
    int layer;
    bf16_t* Q; bf16_t* Kb; bf16_t* Vb; float* U; float* XR; float* YG;
    const float* qn; const float* kn; const float* rotc; const float* rots; float* out;
    DI void operator()(const AccT& acc, const Unit& u, int wr, int wc, int fr, int fq) const {
        const int pn = u.pn;
#pragma unroll
        for (int ai = 0; ai < 2; ++ai)
#pragma unroll
            for (int m = 0; m < 4; ++m) {
                const int row = u.pm * 256 + ai * 128 + wr * 64 + m * 16 + fr;
                const bool prm = row < NP;
                const int b = row >> 12, pos = row & 4095, sq = (row - NP) >> 2, tt = row & 3;
                if (pn <= 1 || (pn == 2 && wc < 2)) {
                    float ss = 0.f;
#pragma unroll
                    for (int bj = 0; bj < 2; ++bj)
#pragma unroll
                        for (int n = 0; n < 2; ++n) { const f32x4 v = acc[ai][bj][m][n]; ss += v.x * v.x + v.y * v.y + v.z * v.z + v.w * v.w; }
                    ss += __shfl_xor(ss, 16); ss += __shfl_xor(ss, 32);
                    const float rinv = rsqrtf(ss * (1.f / 64.f) + EPS);
                    const float* w = (pn <= 1 ? qn : kn) + layer * 64;
                    const int pi = prm ? pos : 4096 + tt;
#pragma unroll
                    for (int n = 0; n < 2; ++n) {
                        const int i = 16 * n + 4 * fq;
                        const f32x4 c4 = *(const f32x4*)(rotc + pi * 32 + i), s4 = *(const f32x4*)(rots + pi * 32 + i);
                        const f32x4 w1 = *(const f32x4*)(w + i), w2 = *(const f32x4*)(w + 32 + i);
                        const f32x4 x1 = acc[ai][0][m][n] * rinv * w1, x2 = acc[ai][1][m][n] * rinv * w2;
                        f32x4 o1 = x1 * c4 - x2 * s4, o2 = x2 * c4 + x1 * s4;
                        if (pn <= 1) {
                            const int head = pn * 4 + wc;
                            o1 = o1 * 0.125f; o2 = o2 * 0.125f;
                            bf16_t* qp = Q + (size_t)row * 512 + head * 64 + i;
                            u32x2 a; a.x = cvt_pk_bf16(o1.x, o1.y); a.y = cvt_pk_bf16(o1.z, o1.w); *(u32x2*)qp = a;
                            u32x2 c; c.x = cvt_pk_bf16(o2.x, o2.y); c.y = cvt_pk_bf16(o2.z, o2.w); *(u32x2*)(qp + 32) = c;
                        } else {
                            const int kvh = wc;
                            bf16_t* kp = Kb + (size_t)row * 128 + kvh * 64 + i;
                            u32x2 a; a.x = cvt_pk_bf16(o1.x, o1.y); a.y = cvt_pk_bf16(o1.z, o1.w); *(u32x2*)kp = a;
                            u32x2 c; c.x = cvt_pk_bf16(o2.x, o2.y); c.y = cvt_pk_bf16(o2.z, o2.w); *(u32x2*)(kp + 32) = c;
                            float* co = nullptr;
                            if (prm) { if (pos >= 3968) co = out + O_PK + ((size_t)(layer * 4 + b) * 128 + (pos - 3968)) * 128; }
                            else co = out + O_SK + ((size_t)(layer * 128 + sq) * 128 + 124 + tt) * 128;
                            if (co) { *(f32x4*)(co + kvh * 64 + i) = o1; *(f32x4*)(co + kvh * 64 + 32 + i) = o2; }
                        }
                    }
                } else if (pn == 2) {
                    const int kvh = wc - 2;
                    float* co = nullptr;
                    if (prm) { if (pos >= 3968) co = out + O_PV + ((size_t)(layer * 4 + b) * 128 + (pos - 3968)) * 128; }
                    else co = out + O_SV + ((size_t)(layer * 128 + sq) * 128 + 124 + tt) * 128;
#pragma unroll
                    for (int bj = 0; bj < 2; ++bj)
#pragma unroll
                        for (int n = 0; n < 2; ++n) {
                            const int d = 32 * bj + 16 * n + 4 * fq; const f32x4 v = acc[ai][bj][m][n];
                            u32x2 a; a.x = cvt_pk_bf16(v.x, v.y); a.y = cvt_pk_bf16(v.z, v.w);
                            *(u32x2*)(Vb + (size_t)row * 128 + kvh * 64 + d) = a;
                            if (co) *(f32x4*)(co + kvh * 64 + d) = v;
                        }
                } else {
                    float* dst = (pn == 3 ? U : (pn == 4 ? XR : YG)) + (size_t)row * 256;
                    float* co = nullptr;
                    if (pn == 4) {
                        if (prm) { if (pos >= 4093) co = out + O_PLC + ((size_t)(layer * 4 + b) * 3 + (pos - 4093)) * 256; }
                        else if (tt >= 1) co = out + O_SLC + ((size_t)(layer * 128 + sq) * 3 + (tt - 1)) * 256;
                    }
#pragma unroll
                    for (int bj = 0; bj < 2; ++bj)
#pragma unroll
                        for (int n = 0; n < 2; ++n) {
                            const int c = 64 * wc + 32 * bj + 16 * n + 4 * fq;
                            *(f32x4*)(dst + c) = acc[ai][bj][m][n];
                            if (co) *(f32x4*)(co + c) = acc[ai][bj][m][n];
                        }
                }
            }
    }
};

struct EpiRes {
    const float* xp; const float* xs_adj; float* X; const float* MODg;
    DI void operator()(const AccT& acc, const Unit& u, int wr, int wc, int fr, int fq) const {
#pragma unroll
        for (int ai = 0; ai < 2; ++ai)
#pragma unroll
            for (int m = 0; m < 4; ++m) {
                const int row = u.pm * 256 + ai * 128 + wr * 64 + m * 16 + fr;
                const float* g = MODg + (size_t)seq_of(row) * NMODALL;
                const float* xs = (row < NP ? xp : xs_adj) + (size_t)row * DM;
                float* xo = X + (size_t)row * DM;
#pragma unroll
                for (int bj = 0; bj < 2; ++bj)
#pragma unroll
                    for (int n = 0; n < 2; ++n) {
                        const int col = u.pn * 256 + bj * 128 + wc * 32 + n * 16 + 4 * fq;
                        *(f32x4*)(xo + col) = *(const f32x4*)(xs + col) + *(const f32x4*)(g + col) * acc[ai][bj][m][n];
                    }
            }
    }
};

struct EpiUp {
    int layer; bf16_t* UP; float* out;
    DI void operator()(const AccT& acc, const Unit& u, int wr, int wc, int fr, int fq) const {
#pragma unroll
        for (int ai = 0; ai < 2; ++ai)
#pragma unroll
            for (int m = 0; m < 4; ++m) {
                const int row = u.pm * 256 + ai * 128 + wr * 64 + m * 16 + fr;
                const int b = row >> 12, pos = row & 4095, sq = (row - NP) >> 2, tt = row & 3;
                float* co = nullptr;
                if (row < NP) { if (pos >= 4094) co = out + O_PFC + ((size_t)(layer * 4 + b) * 2 + (pos - 4094)) * DUP; }
                else if (tt >= 2) co = out + O_SFC + ((size_t)(layer * 128 + sq) * 2 + (tt - 2)) * DUP;
#pragma unroll
                for (int bj = 0; bj < 2; ++bj)
#pragma unroll
                    for (int n = 0; n < 2; ++n) {
                        const int col = u.pn * 256 + bj * 128 + wc * 32 + n * 16 + 4 * fq; const f32x4 v = acc[ai][bj][m][n];
                        u32x2 a; a.x = cvt_pk_bf16(v.x, v.y); a.y = cvt_pk_bf16(v.z, v.w);
                        *(u32x2*)(UP + (size_t)row * DUP + col) = a;
                        if (co) *(f32x4*)(co + col) = v;
                    }
            }
    }
};

template <class Epi>
DI void run_gemm(const PV& p, LAS unsigned char* lds, const bf16_t* A, const bf16_t* Bt, int M, int N, int K, const Epi& E) {
    pg8::Gemm g; g.A = A; g.Bt = Bt; g.M = M; g.N = N; g.K = K;
    pg8::StaticOrder S; S.init(M, N, (int)p.nb, (int)p.bid);
#if SIMPLE_GEMM
    pg8::gemm_simple<Epi>(p, lds, g, S, E);
#else
    pg8::gemm_phase<Epi>(p, lds, g, S, E);
#endif
}

DI void tr_tile(const PV& p, const float* W, int K, int N, bf16_t* Wt, int tile, bool perm, LAS float* t) {
    const int ntn = N >> 6, kb = tile / ntn, nb = tile - kb * ntn, k0 = kb * 64, n0 = nb * 64, tid = p.tid;
#pragma unroll
    for (int i = 0; i < 2; ++i) {
        const int idx = tid + i * 512, r = idx >> 4, c4 = idx & 15;
        const f32x4 v = *(const f32x4*)(W + (size_t)(k0 + r) * N + n0 + 4 * c4);
        t[r * 65 + 4 * c4 + 0] = v.x; t[r * 65 + 4 * c4 + 1] = v.y; t[r * 65 + 4 * c4 + 2] = v.z; t[r * 65 + 4 * c4 + 3] = v.w;
    }
    __syncthreads();
    {
        const int n = tid >> 3, kc = tid & 7;
        const LAS float* s = t + (8 * kc) * 65 + n;
        u32x4 o; o.x = cvt_pk_bf16(s[0], s[65]); o.y = cvt_pk_bf16(s[130], s[195]); o.z = cvt_pk_bf16(s[260], s[325]); o.w = cvt_pk_bf16(s[390], s[455]);
        int nn = n0 + n;
        if (perm) { const int L = nn & 255, wc = L >> 6, bj = (L >> 5) & 1, c32 = L & 31; nn = (nn & ~255) + 128 * bj + 32 * wc + c32; }
        *(u32x4*)(Wt + (size_t)nn * K + k0 + 8 * kc) = o;
    }
    __syncthreads();
}

DI void phase_prologue(const PV& p, LAS unsigned char* lds) {
    LAS float* t = (LAS float*)lds;
    unsigned char* ws = p.ws;
    constexpr int T_ADA = 16 * 96, T_IN = 16 * 24, T_O = 16 * 16, T_UP = 16 * 88, T_DN = 44 * 16;
    constexpr int PER_L = T_ADA + T_IN + T_O + T_UP + T_DN;
    for (int it = p.bid; it < 4 * PER_L; it += p.nb) {
        const int l = it / PER_L; int r = it - l * PER_L;
        if (r < T_ADA) { tr_tile(p, p.in_(I_WADA) + (size_t)l * DM * NMOD, DM, NMOD, (bf16_t*)(ws + W_WTADA) + (size_t)l * NMOD * DM, r, false, t); continue; } r -= T_ADA;
        if (r < T_IN) { tr_tile(p, p.in_(I_WIN) + (size_t)l * DM * DIN, DM, DIN, (bf16_t*)(ws + W_WTIN) + (size_t)l * DIN * DM, r, true, t); continue; } r -= T_IN;
        if (r < T_O) { tr_tile(p, p.in_(I_WO) + (size_t)l * DM * DM, DM, DM, (bf16_t*)(ws + W_WTO) + (size_t)l * DM * DM, r, false, t); continue; } r -= T_O;
        if (r < T_UP) { tr_tile(p, p.in_(I_WUP) + (size_t)l * DM * DUP, DM, DUP, (bf16_t*)(ws + W_WTUP) + (size_t)l * DUP * DM, r, false, t); continue; } r -= T_UP;
        tr_tile(p, p.in_(I_WDN) + (size_t)l * DFF * DM, DFF, DM, (bf16_t*)(ws + W_WTDN) + (size_t)l * DM * DFF, r, false, t);
    }
    const int gt = p.bid * 512 + p.tid, GT = p.nb * 512;
    bf16_t* cs = (bf16_t*)(ws + W_CSILU);
    for (int i = gt; i < 256 * DM; i += GT) {
        const int r = i >> 10, k = i & 1023; float v = 0.f;
        if (r < 4) v = p.in_(I_CP)[r * DM + k]; else if (r < NSEQ) v = p.in_(I_CS)[(r - 4) * DM + k];
        cs[i] = f2bf(v / (1.f + __expf(-v)));
    }
    float* rc = (float*)(ws + W_ROTC); float* rs = (float*)(ws + W_ROTS);
    for (int i = gt; i < 4100 * 32; i += GT) {
        const int pi = i >> 5, j = i & 31; const double pos = pi < 4096 ? (double)pi : (double)(8192 + pi - 4096);
        const double inv = exp(-(double)j * (1.0 / 32.0) * 9.210340371976184);
        const double ang = pos * inv; rc[i] = (float)cos(ang); rs[i] = (float)sin(ang);
    }
    float* abar = (float*)(ws + W_ABAR); float* bb = (float*)(ws + W_BB);
    for (int i = gt; i < 4 * 16 * 64; i += GT) {
        const int l = i >> 10, g = (i >> 6) & 15, s = i & 63;
        const double are = p.in_(I_ARE)[i], aim = p.in_(I_AIM)[i], dt = exp((double)p.in_(I_LDT)[l * 16 + g]);
        const double mag = exp(are * dt), abr = mag * cos(aim * dt), abi = mag * sin(aim * dt);
        abar[2 * i] = (float)abr; abar[2 * i + 1] = (float)abi;
        const double nr = abr - 1.0, ni = abi, den = are * are + aim * aim;
        const double fr_ = (nr * are + ni * aim) / den, fi_ = (ni * are - nr * aim) / den;
        for (int c = 0; c < 16; ++c) {
            const double br = p.in_(I_BRE)[(size_t)i * 16 + c], bi = p.in_(I_BIM)[(size_t)i * 16 + c];
            bb[(((size_t)(l * 16 + g) * 2 + 0) * 64 + s) * 16 + c] = (float)(fr_ * br - fi_ * bi);
            bb[(((size_t)(l * 16 + g) * 2 + 1) * 64 + s) * 16 + c] = (float)(fr_ * bi + fi_ * br);
        }
    }
}

DI void phase_norm(const PV& p, const float* xp, const float* xs_adj, const float* w, const float* mod_sh, bf16_t* H) {
    const int wave = p.tid >> 6, lane = p.tid & 63;
    for (int row = p.bid * 8 + wave; row < NTOK; row += p.nb * 8) {
        const float* x = (row < NP ? xp : xs_adj) + (size_t)row * DM;
        const float* sh = mod_sh + (size_t)seq_of(row) * NMODALL; const float* sc = sh + DM;
        f32x4 v[4]; float ss = 0.f;
#pragma unroll
        for (int j = 0; j < 4; ++j) { v[j] = *(const f32x4*)(x + 256 * j + 4 * lane); ss += v[j].x * v[j].x + v[j].y * v[j].y + v[j].z * v[j].z + v[j].w * v[j].w; }
        const float rinv = rsqrtf(wave_sum(ss) * (1.f / DM) + EPS);
#pragma unroll
        for (int j = 0; j < 4; ++j) {
            const int c = 256 * j + 4 * lane;
            const f32x4 ww = *(const f32x4*)(w + c), s1 = *(const f32x4*)(sc + c), s0 = *(const f32x4*)(sh + c);
            const f32x4 o = v[j] * rinv * ww * (s1 + 1.f) + s0;
            u32x2 a; a.x = cvt_pk_bf16(o.x, o.y); a.y = cvt_pk_bf16(o.z, o.w);
            *(u32x2*)(H + (size_t)row * DM + c) = a;
        }
    }
}

DI void phase_convglu(const PV& p, int layer) {
    const bf16_t* UP = (const bf16_t*)(p.ws + W_UP); bf16_t* ACT = (bf16_t*)(p.ws + W_ACT);
    const float* cw = p.in_(I_FCW) + (size_t)layer * 3 * DUP; const float* cb = p.in_(I_FCB) + (size_t)layer * DUP;
    const float* st = p.in_(I_SFC) + (size_t)layer * 128 * 2 * DUP;
    constexpr int NCG = DFF / 4;
    const long total = (long)(NTOK / 4) * NCG;
    for (long it = (long)p.bid * 512 + p.tid; it < total; it += (long)p.nb * 512) {
        const int run = (int)(it / NCG), cg4 = (int)(it - (long)run * NCG), c = cg4 * 4, row0 = run * 4;
        f32x4 w[2][3], bias[2];
#pragma unroll
        for (int h = 0; h < 2; ++h) { bias[h] = *(const f32x4*)(cb + h * DFF + c);
#pragma unroll
            for (int j = 0; j < 3; ++j) w[h][j] = *(const f32x4*)(cw + j * DUP + h * DFF + c); }
        f32x4 xm2[2], xm1[2];
        const bool prm = row0 < NP;
#pragma unroll
        for (int h = 0; h < 2; ++h) {
            if (prm) {
                if ((row0 & 4095) == 0) { xm2[h] = (f32x4){0.f, 0.f, 0.f, 0.f}; xm1[h] = xm2[h]; }
                else {
                    const u32x2 a = *(const u32x2*)(UP + (size_t)(row0 - 2) * DUP + h * DFF + c), b = *(const u32x2*)(UP + (size_t)(row0 - 1) * DUP + h * DFF + c);
                    xm2[h] = (f32x4){__uint_as_float(a.x << 16), __uint_as_float(a.x & 0xffff0000u), __uint_as_float(a.y << 16), __uint_as_float(a.y & 0xffff0000u)};
                    xm1[h] = (f32x4){__uint_as_float(b.x << 16), __uint_as_float(b.x & 0xffff0000u), __uint_as_float(b.y << 16), __uint_as_float(b.y & 0xffff0000u)};
                }
            } else {
                const int sq = (row0 - NP) >> 2;
                xm2[h] = *(const f32x4*)(st + ((size_t)sq * 2 + 0) * DUP + h * DFF + c);
                xm1[h] = *(const f32x4*)(st + ((size_t)sq * 2 + 1) * DUP + h * DFF + c);
            }
        }
#pragma unroll
        for (int t = 0; t < 4; ++t) {
            f32x4 y[2];
#pragma unroll
            for (int h = 0; h < 2; ++h) {
                const u32x2 a = *(const u32x2*)(UP + (size_t)(row0 + t) * DUP + h * DFF + c);
                const f32x4 x0 = (f32x4){__uint_as_float(a.x << 16), __uint_as_float(a.x & 0xffff0000u), __uint_as_float(a.y << 16), __uint_as_float(a.y & 0xffff0000u)};
                y[h] = bias[h] + w[h][0] * xm2[h] + w[h][1] * xm1[h] + w[h][2] * x0;
                xm2[h] = xm1[h]; xm1[h] = x0;
            }
            u32x2 o; o.x = cvt_pk_bf16(gelu_t(y[0].x) * y[1].x, gelu_t(y[0].y) * y[1].y); o.y = cvt_pk_bf16(gelu_t(y[0].z) * y[1].z, gelu_t(y[0].w) * y[1].w);
            *(u32x2*)(ACT + (size_t)(row0 + t) * DFF + c) = o;
        }
    }
}

constexpr int KS_STR = 72, VT_STR = 280, PS_STR = 168;
DI void attn_prompt_item(const PV& p, int layer, int item, LAS unsigned char* lds) {
    const int tid = p.tid, wave = tid >> 6, lane = tid & 63, sub = lane & 15, q = lane >> 4;
    const int b = item >> 6, qblk = (item >> 1) & 31, kvh = item & 1;
    const bf16_t* Q = (const bf16_t*)(p.ws + W_Q); const bf16_t* Kb = (const bf16_t*)(p.ws + W_KB); const bf16_t* Vb = (const bf16_t*)(p.ws + W_VB);
    float* OATT = (float*)(p.ws + W_OATT);
    LAS bf16_t* Ks = (LAS bf16_t*)lds;
    LAS bf16_t* Vt = Ks + 256 * KS_STR;
    LAS bf16_t* Ps = Vt + 64 * VT_STR + wave * 16 * PS_STR;
    const int tok0 = b * 4096 + qblk * 128;
    {
        const int key = tid >> 1, hf = tid & 1; const bool valid = (qblk > 0) || key >= 128;
        u32x4 v[4];
#pragma unroll
        for (int i = 0; i < 4; ++i) v[i] = valid ? *(const u32x4*)(Kb + (size_t)(tok0 - 128 + key) * 128 + kvh * 64 + hf * 32 + 8 * i) : (u32x4){0u, 0u, 0u, 0u};
#pragma unroll
        for (int i = 0; i < 4; ++i) *(LAS u32x4*)(Ks + key * KS_STR + hf * 32 + 8 * i) = v[i];
    }
    {
        const int key = tid & 255, dh = tid >> 8; const bool valid = (qblk > 0) || key >= 128;
        u32x4 v[4];
#pragma unroll
        for (int i = 0; i < 4; ++i) v[i] = valid ? *(const u32x4*)(Vb + (size_t)(tok0 - 128 + key) * 128 + kvh * 64 + dh * 32 + 8 * i) : (u32x4){0u, 0u, 0u, 0u};
#pragma unroll
        for (int i = 0; i < 4; ++i) {
            const unsigned wv[4] = {v[i].x, v[i].y, v[i].z, v[i].w};
#pragma unroll
            for (int j = 0; j < 4; ++j) {
                Vt[(dh * 32 + 8 * i + 2 * j) * VT_STR + key] = (bf16_t)(wv[j] & 0xffffu);
                Vt[(dh * 32 + 8 * i + 2 * j + 1) * VT_STR + key] = (bf16_t)(wv[j] >> 16);
            }
        }
        if (tid < 64) { for (int c = 256; c < VT_STR; ++c) Vt[tid * VT_STR + c] = 0; }
    }
    for (int i = lane; i < 16 * 24; i += 64) Ps[(i / 24) * PS_STR + 144 + (i % 24)] = 0;
    __syncthreads();
    const int qloc0 = 16 * wave;
#pragma unroll 1
    for (int hh = 0; hh < 4; ++hh) {
        const int head = kvh * 4 + hh;
        int subm = sub; asm volatile("" : "+v"(subm));
        const float sink = p.in_(I_SINK)[layer * 8 + head];
        bf16x8 qf[2];
#pragma unroll
        for (int s = 0; s < 2; ++s) qf[s] = *(const bf16x8*)(Q + (size_t)(tok0 + qloc0 + sub) * 512 + head * 64 + 32 * s + 8 * q);
        f32x4 S[9];
#pragma unroll
        for (int jt = 0; jt < 9; ++jt) {
            f32x4 a = {0.f, 0.f, 0.f, 0.f};
#pragma unroll
            for (int s = 0; s < 2; ++s) {
                const bf16x8 kf = *(const LAS bf16x8*)(Ks + (16 * (wave + jt) + sub) * KS_STR + 32 * s + 8 * q);
                a = MFMA16(qf[s], kf, a);
            }
            S[jt] = a;
        }
        float mx[4], sm[4];
#pragma unroll
        for (int r = 0; r < 4; ++r) {
            const int i = qloc0 + 4 * q + r; float m = -INFINITY;
#pragma unroll
            for (int jt = 0; jt < 9; ++jt) {
                const int j = 16 * (wave + jt) + subm;
                const bool ok = (j >= i + 1) && (j <= i + 128) && (qblk > 0 || j >= 128);
                const float v = ok ? S[jt][r] : -INFINITY; S[jt][r] = v; m = fmaxf(m, v);
            }
            m = fmaxf(max16(m), sink); mx[r] = m;
            float s = 0.f;
#pragma unroll
            for (int jt = 0; jt < 9; ++jt) { const float e = __expf(S[jt][r] - m); S[jt][r] = e; s += e; }
            sm[r] = 1.f / (sum16(s) + __expf(sink - m));
        }
#pragma unroll
        for (int jt = 0; jt < 9; ++jt)
#pragma unroll
            for (int r = 0; r < 4; ++r) Ps[(4 * q + r) * PS_STR + 16 * jt + sub] = f2bf(S[jt][r]);
        __syncthreads();
        f32x4 O[4];
#pragma unroll
        for (int dt = 0; dt < 4; ++dt) O[dt] = (f32x4){0.f, 0.f, 0.f, 0.f};
#pragma unroll
        for (int s = 0; s < 5; ++s) {
            const bf16x8 pf = *(const LAS bf16x8*)(Ps + sub * PS_STR + 32 * s + 8 * q);
#pragma unroll
            for (int dt = 0; dt < 4; ++dt) {
                const bf16x8 vf = *(const LAS bf16x8*)(Vt + (16 * dt + sub) * VT_STR + 16 * wave + 32 * s + 8 * q);
                O[dt] = MFMA16(pf, vf, O[dt]);
            }
        }
#pragma unroll
        for (int dt = 0; dt < 4; ++dt)
#pragma unroll
            for (int r = 0; r < 4; ++r) OATT[(size_t)(tok0 + qloc0 + 4 * q + r) * 512 + head * 64 + 16 * dt + sub] = O[dt][r] * sm[r];
        __syncthreads();
    }
    __syncthreads();
}

DI void attn_sample_item(const PV& p, int layer, int item, LAS unsigned char* lds) {
    const int tid = p.tid, s = item >> 1, kvh = item & 1;
    const bf16_t* Q = (const bf16_t*)(p.ws + W_Q); const bf16_t* Kb = (const bf16_t*)(p.ws + W_KB); const bf16_t* Vb = (const bf16_t*)(p.ws + W_VB);
    float* OATT = (float*)(p.ws + W_OATT);
    LAS float* Kf = (LAS float*)lds;
    LAS float* Vf = Kf + 132 * 65;
    LAS float* Qs = Vf + 132 * 64;
    LAS float* Sc = Qs + 16 * 64;
    const float* ck = p.in_(I_CK) + ((size_t)(layer * 128 + s) * 128) * 128 + kvh * 64;
    const float* cv = p.in_(I_CV) + ((size_t)(layer * 128 + s) * 128) * 128 + kvh * 64;
    float* sk = p.out + O_SK + ((size_t)(layer * 128 + s) * 128) * 128 + kvh * 64;
    float* sv = p.out + O_SV + ((size_t)(layer * 128 + s) * 128) * 128 + kvh * 64;
    for (int i = tid; i < 132 * 64; i += 512) {
        const int j = i >> 6, d = i & 63; float kv, vv;
        if (j < 128) { kv = ck[(size_t)j * 128 + d]; vv = cv[(size_t)j * 128 + d]; if (j >= 4) { sk[(size_t)(j - 4) * 128 + d] = kv; sv[(size_t)(j - 4) * 128 + d] = vv; } }
        else { const size_t rw = (size_t)(NP + 4 * s + (j - 128)) * 128 + kvh * 64 + d; kv = bf2f(Kb[rw]); vv = bf2f(Vb[rw]); }
        Kf[j * 65 + d] = kv; Vf[j * 64 + d] = vv;
    }
    for (int i = tid; i < 16 * 64; i += 512) { const int rr = i >> 6, d = i & 63, hh = rr >> 2, t = rr & 3; Qs[i] = bf2f(Q[(size_t)(NP + 4 * s + t) * 512 + (kvh * 4 + hh) * 64 + d]); }
    __syncthreads();
    const int rr = tid >> 5, jl = tid & 31, hh = rr >> 2, t = rr & 3;
    const float sink = p.in_(I_SINK)[layer * 8 + kvh * 4 + hh];
    float sc[5]; float m = -INFINITY;
#pragma unroll
    for (int it = 0; it < 5; ++it) {
        __builtin_amdgcn_sched_barrier(0);
        const int j = jl + 32 * it; float a = -INFINITY;
        if (j < 132 && j >= t + 1 && j <= t + 128) { a = 0.f;
#pragma unroll 8
            for (int d = 0; d < 64; ++d) a += Qs[rr * 64 + d] * Kf[j * 65 + d]; }
        sc[it] = a; m = fmaxf(m, a);
    }
#pragma unroll
    for (int o = 1; o < 32; o <<= 1) m = fmaxf(m, __shfl_xor(m, o));
    m = fmaxf(m, sink);
    float sum = 0.f;
#pragma unroll
    for (int it = 0; it < 5; ++it) { const float e = __expf(sc[it] - m); sc[it] = e; sum += e; }
#pragma unroll
    for (int o = 1; o < 32; o <<= 1) sum += __shfl_xor(sum, o);
    const float inv = 1.f / (sum + __expf(sink - m));
#pragma unroll
    for (int it = 0; it < 5; ++it) { const int j = jl + 32 * it; if (j < 132) Sc[rr * 136 + j] = sc[it] * inv; }
    __syncthreads();
#pragma unroll
    for (int dd = 0; dd < 2; ++dd) {
        const int d = jl + 32 * dd; float a = 0.f;
#pragma unroll 4
        for (int j = 0; j < 132; ++j) a += Sc[rr * 136 + j] * Vf[j * 64 + d];
        OATT[(size_t)(NP + 4 * s + t) * 512 + (kvh * 4 + hh) * 64 + d] = a;
    }
    __syncthreads();
}


DI void attn_prompt4_item(const PV& p, int layer, int item, LAS unsigned char* lds) {
    const int tid = p.tid, kvh = item & 1, grp = (item >> 1) & 1023, b = item >> 11;
    const bf16_t* Q = (const bf16_t*)(p.ws + W_Q); const bf16_t* Kb = (const bf16_t*)(p.ws + W_KB); const bf16_t* Vb = (const bf16_t*)(p.ws + W_VB);
    float* OATT = (float*)(p.ws + W_OATT);
    LAS float* Kf = (LAS float*)lds;
    LAS float* Vf = Kf + 132 * 65;
    LAS float* Qs = Vf + 132 * 64;
    LAS float* Sc = Qs + 16 * 64;
    const int r0 = b * 4096 + 4 * grp, p0 = 4 * grp;
    for (int i = tid; i < 132 * 64; i += 512) {
        const int j = i >> 6, d = i & 63; float kv = 0.f, vv = 0.f;
        if (p0 - 128 + j >= 0) { const size_t rw = (size_t)(r0 - 128 + j) * 128 + kvh * 64 + d; kv = bf2f(Kb[rw]); vv = bf2f(Vb[rw]); }
        Kf[j * 65 + d] = kv; Vf[j * 64 + d] = vv;
    }
    for (int i = tid; i < 16 * 64; i += 512) { const int rr = i >> 6, d = i & 63, hh = rr >> 2, t = rr & 3; Qs[i] = bf2f(Q[(size_t)(r0 + t) * 512 + (kvh * 4 + hh) * 64 + d]); }
    __syncthreads();
    const int rr = tid >> 5, jl = tid & 31, hh = rr >> 2, t = rr & 3;
    const float sink = p.in_(I_SINK)[layer * 8 + kvh * 4 + hh];
    float sc[5]; float m = -INFINITY;
#pragma unroll
    for (int it = 0; it < 5; ++it) {
        __builtin_amdgcn_sched_barrier(0);
        const int j = jl + 32 * it; float a = -INFINITY;
        if (j < 132 && j >= t + 1 && j <= t + 128 && p0 - 128 + j >= 0) { a = 0.f;
#pragma unroll 8
            for (int d = 0; d < 64; ++d) a += Qs[rr * 64 + d] * Kf[j * 65 + d]; }
        sc[it] = a; m = fmaxf(m, a);
    }
#pragma unroll
    for (int o = 1; o < 32; o <<= 1) m = fmaxf(m, __shfl_xor(m, o));
    m = fmaxf(m, sink);
    float sum = 0.f;
#pragma unroll
    for (int it = 0; it < 5; ++it) { const float e = __expf(sc[it] - m); sc[it] = e; sum += e; }
#pragma unroll
    for (int o = 1; o < 32; o <<= 1) sum += __shfl_xor(sum, o);
    const float inv = 1.f / (sum + __expf(sink - m));
#pragma unroll
    for (int it = 0; it < 5; ++it) { const int j = jl + 32 * it; if (j < 132) Sc[rr * 136 + j] = sc[it] * inv; }
    __syncthreads();
#pragma unroll
    for (int dd = 0; dd < 2; ++dd) {
        const int d = jl + 32 * dd; float a = 0.f;
#pragma unroll 4
        for (int j = 0; j < 132; ++j) a += Sc[rr * 136 + j] * Vf[j * 64 + d];
        OATT[(size_t)(r0 + t) * 512 + (kvh * 4 + hh) * 64 + d] = a;
    }
    __syncthreads();
}

DI void attn_prompt16_item(const PV& p, int layer, int item, LAS unsigned char* lds) {
    const int tid = p.tid, kvh = item & 1, grp = (item >> 1) & 255, b = item >> 9;
    const bf16_t* Q = (const bf16_t*)(p.ws + W_Q); const bf16_t* Kb = (const bf16_t*)(p.ws + W_KB); const bf16_t* Vb = (const bf16_t*)(p.ws + W_VB);
    float* OATT = (float*)(p.ws + W_OATT);
    LAS float* Kf = (LAS float*)lds;
    LAS float* Vf = Kf + 144 * 68;
    LAS float* Qs = Vf + 144 * 64;
    LAS float* Sc = Qs + 64 * 64;
    const int p0 = 16 * grp, r0 = b * 4096 + p0;
    for (int i = tid; i < 144 * 8; i += 512) {
        const int j = i >> 3, c8 = (i & 7) * 8;
        u32x4 kk = {0u, 0u, 0u, 0u}, vv = kk;
        if (p0 - 128 + j >= 0) { const size_t rw = (size_t)(r0 - 128 + j) * 128 + kvh * 64 + c8; kk = *(const u32x4*)(Kb + rw); vv = *(const u32x4*)(Vb + rw); }
        const unsigned kw[4] = {kk.x, kk.y, kk.z, kk.w}, vw[4] = {vv.x, vv.y, vv.z, vv.w};
#pragma unroll
        for (int e = 0; e < 4; ++e) {
            Kf[j * 68 + c8 + 2 * e] = __uint_as_float(kw[e] << 16); Kf[j * 68 + c8 + 2 * e + 1] = __uint_as_float(kw[e] & 0xffff0000u);
            Vf[j * 64 + c8 + 2 * e] = __uint_as_float(vw[e] << 16); Vf[j * 64 + c8 + 2 * e + 1] = __uint_as_float(vw[e] & 0xffff0000u);
        }
    }
    for (int i = tid; i < 64 * 8; i += 512) {
        const int rr = i >> 3, c8 = (i & 7) * 8, hh = rr >> 4, t = rr & 15;
        const u32x4 qq = *(const u32x4*)(Q + (size_t)(r0 + t) * 512 + (kvh * 4 + hh) * 64 + c8);
        const unsigned qw[4] = {qq.x, qq.y, qq.z, qq.w};
#pragma unroll
        for (int e = 0; e < 4; ++e) { Qs[rr * 64 + c8 + 2 * e] = __uint_as_float(qw[e] << 16); Qs[rr * 64 + c8 + 2 * e + 1] = __uint_as_float(qw[e] & 0xffff0000u); }
    }
    __syncthreads();
    const int rp = tid >> 4, jl = tid & 15, t = rp & 15, hp = rp >> 4, rrA = hp * 16 + t, rrB = (hp + 2) * 16 + t;
    const float sinkA = p.in_(I_SINK)[layer * 8 + kvh * 4 + hp], sinkB = p.in_(I_SINK)[layer * 8 + kvh * 4 + hp + 2];
    f32x4 qa[16], qb[16];
#pragma unroll
    for (int d4 = 0; d4 < 16; ++d4) { qa[d4] = *(const LAS f32x4*)(Qs + rrA * 64 + 4 * d4); qb[d4] = *(const LAS f32x4*)(Qs + rrB * 64 + 4 * d4); }
    float sa[9], sb[9]; float mA = -INFINITY, mB = -INFINITY;
#pragma unroll
    for (int it = 0; it < 9; ++it) {
        const int j = jl + 16 * it; float a = -INFINITY, bq = -INFINITY;
        if (j >= t + 1 && j <= t + 128 && p0 - 128 + j >= 0) { f32x4 a4 = {0.f, 0.f, 0.f, 0.f}, b4 = a4;
#pragma unroll
            for (int d4 = 0; d4 < 16; ++d4) { const f32x4 kv4 = *(const LAS f32x4*)(Kf + j * 68 + 4 * d4); a4 += qa[d4] * kv4; b4 += qb[d4] * kv4; }
            a = (a4.x + a4.y) + (a4.z + a4.w); bq = (b4.x + b4.y) + (b4.z + b4.w); }
        sa[it] = a; sb[it] = bq; mA = fmaxf(mA, a); mB = fmaxf(mB, bq);
    }
#pragma unroll
    for (int o = 1; o < 16; o <<= 1) { mA = fmaxf(mA, __shfl_xor(mA, o)); mB = fmaxf(mB, __shfl_xor(mB, o)); }
    mA = fmaxf(mA, sinkA); mB = fmaxf(mB, sinkB);
    float sumA = 0.f, sumB = 0.f;
#pragma unroll
    for (int it = 0; it < 9; ++it) { const float ea = __expf(sa[it] - mA), eb = __expf(sb[it] - mB); sa[it] = ea; sb[it] = eb; sumA += ea; sumB += eb; }
#pragma unroll
    for (int o = 1; o < 16; o <<= 1) { sumA += __shfl_xor(sumA, o); sumB += __shfl_xor(sumB, o); }
    const float invA = 1.f / (sumA + __expf(sinkA - mA)), invB = 1.f / (sumB + __expf(sinkB - mB));
#pragma unroll
    for (int it = 0; it < 9; ++it) { Sc[rrA * 148 + jl + 16 * it] = sa[it] * invA; Sc[rrB * 148 + jl + 16 * it] = sb[it] * invB; }
    __syncthreads();
    f32x4 oa = {0.f, 0.f, 0.f, 0.f}, ob = oa;
#pragma unroll 4
    for (int j = 0; j < 144; ++j) {
        const float pa = Sc[rrA * 148 + j], pb = Sc[rrB * 148 + j];
        const f32x4 v4 = *(const LAS f32x4*)(Vf + j * 64 + 4 * jl);
        oa += v4 * pa; ob += v4 * pb;
    }
    *(f32x4*)(OATT + (size_t)(r0 + t) * 512 + (kvh * 4 + hp) * 64 + 4 * jl) = oa;
    *(f32x4*)(OATT + (size_t)(r0 + t) * 512 + (kvh * 4 + hp + 2) * 64 + 4 * jl) = ob;
    __syncthreads();
}
DI void attn_norm_item(const PV& p, int layer, int item) {
    const int wave = p.tid >> 6, lane = p.tid & 63;
    const float* OATT = (const float*)(p.ws + W_OATT); bf16_t* O = (bf16_t*)(p.ws + W_O);
    const float* on = p.in_(I_ON) + layer * DM;
    for (int rr = wave; rr < 256; rr += 8) {
        const int row = item * 256 + rr;
        const f32x4 a = *(const f32x4*)(OATT + (size_t)row * 512 + 4 * lane), b = *(const f32x4*)(OATT + (size_t)row * 512 + 256 + 4 * lane);
        float ss = a.x * a.x + a.y * a.y + a.z * a.z + a.w * a.w + b.x * b.x + b.y * b.y + b.z * b.z + b.w * b.w;
        const float rinv = rsqrtf(wave_sum(ss) * (1.f / 512.f) + EPS);
        const f32x4 wa = *(const f32x4*)(on + 4 * lane), wb = *(const f32x4*)(on + 256 + 4 * lane);
        const f32x4 oa = a * rinv * wa, ob = b * rinv * wb;
        u32x2 x; x.x = cvt_pk_bf16(oa.x, oa.y); x.y = cvt_pk_bf16(oa.z, oa.w); *(u32x2*)(O + (size_t)row * DM + 4 * lane) = x;
        u32x2 y; y.x = cvt_pk_bf16(ob.x, ob.y); y.y = cvt_pk_bf16(ob.z, ob.w); *(u32x2*)(O + (size_t)row * DM + 256 + 4 * lane) = y;
    }
}

struct cpx { float re, im; };
DI cpx cmul(cpx a, cpx b) { return cpx{a.re * b.re - a.im * b.im, a.re * b.im + a.im * b.re}; }
DI cpx cfma(cpx a, cpx x, cpx y) { return cpx{a.re * x.re - a.im * x.im + y.re, a.re * x.im + a.im * x.re + y.im}; }

template <bool SAMPLE, bool PASS2>
DI void ssm_item(const PV& p, int layer, int item, LAS unsigned char* lds) {
    const int tid = p.tid, wave = tid >> 6, lane = tid & 63, sub = lane & 15, q = lane >> 4;
    int row0, b = 0, c = 0;
    if (SAMPLE) row0 = NP + item * 64; else { b = item >> 6; c = item & 63; row0 = b * 4096 + c * 64; }
    const float* U = (const float*)(p.ws + W_U);
    const float* ABAR = (const float*)(p.ws + W_ABAR); const float* BB = (const float*)(p.ws + W_BB);
    float* SST = (float*)(p.ws + W_SST);
    LAS bf16_t* Hs = (LAS bf16_t*)lds + wave * 16 * 136;
    LAS bf16_t* Gs = (LAS bf16_t*)lds + 8 * 16 * 136;
    LAS float* rowss = (LAS float*)(Gs + 64 * 264);
    if (PASS2) { if (tid < 64) rowss[tid] = 0.f; }
#pragma unroll 1
    for (int gi = 0; gi < 2; ++gi) {
        const int g = 2 * wave + gi, lg = layer * 16 + g;
        cpx a[4], a4[4], hin[4];
        bf16x8 Bf[8], Cf[4];
#pragma unroll
        for (int i = 0; i < 4; ++i) {
            const int st = 16 * i + sub;
            a[i] = cpx{ABAR[((size_t)lg * 64 + st) * 2], ABAR[((size_t)lg * 64 + st) * 2 + 1]};
            const cpx a2 = cmul(a[i], a[i]); a4[i] = cmul(a2, a2);
            hin[i] = cpx{0.f, 0.f};
#pragma unroll
            for (int part = 0; part < 2; ++part) {
                f32x4 v0 = {0.f, 0.f, 0.f, 0.f}, v1 = v0;
                if (q < 2) { const float* src = BB + (((size_t)lg * 2 + part) * 64 + st) * 16 + 8 * q; v0 = *(const f32x4*)src; v1 = *(const f32x4*)(src + 4); }
                Bf[2 * i + part] = pack8(v0, v1);
            }
        }
#pragma unroll
        for (int s = 0; s < 4; ++s) {
            const int part = q >> 1, p0 = 16 * s + 8 * (q & 1);
            const float* src = (part ? p.in_(I_CIM) : p.in_(I_CRE)) + ((size_t)lg * 16 + sub) * 64 + p0;
            f32x4 v0 = *(const f32x4*)src, v1 = *(const f32x4*)(src + 4);
            if (part) { v0 = -v0; v1 = -v1; }
            Cf[s] = pack8(v0, v1);
        }
        if (PASS2 && !SAMPLE) {
            cpx a64[4], hh4[4];
#pragma unroll
            for (int i = 0; i < 4; ++i) { const cpx a8 = cmul(a4[i], a4[i]), a16 = cmul(a8, a8), a32 = cmul(a16, a16); a64[i] = cmul(a32, a32); hh4[i] = cpx{0.f, 0.f}; }
            const float* sp0 = SST + (((size_t)(b * 64) * 16 + g) * 64 + sub) * 2;
#pragma unroll 1
            for (int j0 = 0; j0 < c; j0 += 4) {
                float2 sv[4][4];
#pragma unroll
                for (int u = 0; u < 4; ++u)
#pragma unroll
                    for (int i = 0; i < 4; ++i) { const int jj = (j0 + u < c) ? j0 + u : c - 1; sv[u][i] = *(const float2*)(sp0 + (size_t)jj * 2048 + i * 32); }
#pragma unroll
                for (int u = 0; u < 4; ++u)
                    if (j0 + u < c) {
#pragma unroll
                        for (int i = 0; i < 4; ++i) hh4[i] = cfma(a64[i], hh4[i], cpx{sv[u][i].x, sv[u][i].y});
                    }
            }
#pragma unroll
            for (int i = 0; i < 4; ++i) hin[i] = hh4[i];
        }
        const float dcoef = p.in_(I_SD)[layer * 256 + g * 16 + sub];
#pragma unroll 1
        for (int tt = 0; tt < 4; ++tt) {
            f32x4 u0 = {0.f, 0.f, 0.f, 0.f}, u1 = u0;
            if (q < 2) { const float* src = U + (size_t)(row0 + 16 * tt + sub) * 256 + g * 16 + 8 * q; u0 = *(const f32x4*)src; u1 = *(const f32x4*)(src + 4); }
            const bf16x8 Uf = pack8(u0, u1);
            f32x4 acc[8];
#pragma unroll
            for (int n = 0; n < 8; ++n) acc[n] = MFMA16(Uf, Bf[n], ((f32x4){0.f, 0.f, 0.f, 0.f}));
#pragma unroll
            for (int i = 0; i < 4; ++i) {
                const int st = 16 * i + sub;
                cpx bu[4];
#pragma unroll
                for (int r = 0; r < 4; ++r) bu[r] = cpx{acc[2 * i][r], acc[2 * i + 1][r]};
                cpx in;
                if (SAMPLE) {
                    const int sq = (row0 - NP) / 4 + 4 * tt + q;
                    const size_t so = ((size_t)(layer * 128 + sq) * 16 + g) * 64 + st;
                    in = cpx{p.in_(I_SRE)[so], p.in_(I_SIM)[so]};
                } else {
                    cpx x = bu[0]; x = cfma(a[i], x, bu[1]); x = cfma(a[i], x, bu[2]); x = cfma(a[i], x, bu[3]);
                    cpx e[4];
#pragma unroll
                    for (int k = 0; k < 4; ++k) e[k] = cpx{__shfl(x.re, sub + 16 * k), __shfl(x.im, sub + 16 * k)};
                    const cpx E0 = cfma(a4[i], hin[i], e[0]), E1 = cfma(a4[i], E0, e[1]), E2 = cfma(a4[i], E1, e[2]), E3 = cfma(a4[i], E2, e[3]);
                    in = q == 0 ? hin[i] : (q == 1 ? E0 : (q == 2 ? E1 : E2));
                    hin[i] = E3;
                }
                if (PASS2) {
                    cpx h = in;
#pragma unroll
                    for (int r = 0; r < 4; ++r) {
                        h = cfma(a[i], h, bu[r]);
                        Hs[(4 * q + r) * 136 + (2 * i) * 16 + sub] = f2bf(h.re);
                        Hs[(4 * q + r) * 136 + (2 * i + 1) * 16 + sub] = f2bf(h.im);
                    }
                    if (SAMPLE) {
                        const int sq = (row0 - NP) / 4 + 4 * tt + q;
                        const size_t so = ((size_t)(layer * 128 + sq) * 16 + g) * 64 + st;
                        p.out[O_SRE + so] = h.re; p.out[O_SIM + so] = h.im;
                    }
                }
            }
            if (PASS2) {
                __builtin_amdgcn_wave_barrier(); asm volatile("s_waitcnt lgkmcnt(0)" ::: "memory");
                f32x4 Y = {0.f, 0.f, 0.f, 0.f};
#pragma unroll
                for (int s = 0; s < 4; ++s) { const bf16x8 hf = *(const LAS bf16x8*)(Hs + sub * 136 + 32 * s + 8 * q); Y = MFMA16(hf, Cf[s], Y); }
#pragma unroll
                for (int r = 0; r < 4; ++r) {
                    const int t = 16 * tt + 4 * q + r;
                    const float uu = U[(size_t)(row0 + t) * 256 + g * 16 + sub];
                    const float gg = gelu_t(Y[r] + dcoef * uu);
                    Gs[t * 264 + g * 16 + sub] = f2bf(gg);
                }
                __builtin_amdgcn_wave_barrier(); asm volatile("s_waitcnt lgkmcnt(0)" ::: "memory");
            }
        }
        if (!SAMPLE && q == 0) {
#pragma unroll
            for (int i = 0; i < 4; ++i) {
                const int st = 16 * i + sub;
                if (!PASS2) { float* sp = SST + (((size_t)(b * 64 + c) * 16 + g) * 64 + st) * 2; sp[0] = hin[i].re; sp[1] = hin[i].im; }
                else if (c == 63) { const size_t so = ((size_t)(layer * 4 + b) * 16 + g) * 64 + st; p.out[O_PRE + so] = hin[i].re; p.out[O_PIM + so] = hin[i].im; }
            }
        }
    }
    if (PASS2) {
        __syncthreads();
        f32x4 z[2][4];
#pragma unroll
        for (int n2 = 0; n2 < 2; ++n2)
#pragma unroll
            for (int mt = 0; mt < 4; ++mt) z[n2][mt] = (f32x4){0.f, 0.f, 0.f, 0.f};
        const float* wg = p.in_(I_WGLU) + (size_t)layer * 256 * 256;
#pragma unroll 2
        for (int s = 0; s < 8; ++s) {
            bf16x8 bfr[2];
#pragma unroll
            for (int n2 = 0; n2 < 2; ++n2) {
                const float* src = wg + (size_t)(32 * s + 8 * q) * 256 + 16 * (2 * wave + n2) + sub;
                f32x4 v0 = {src[0], src[256], src[512], src[768]}, v1 = {src[1024], src[1280], src[1536], src[1792]};
                bfr[n2] = pack8(v0, v1);
            }
#pragma unroll
            for (int mt = 0; mt < 4; ++mt) {
                const bf16x8 af = *(const LAS bf16x8*)(Gs + (16 * mt + sub) * 264 + 32 * s + 8 * q);
#pragma unroll
                for (int n2 = 0; n2 < 2; ++n2) z[n2][mt] = MFMA16(af, bfr[n2], z[n2][mt]);
            }
        }
        float bg[2], onw[2]; float gk[2][4][4];
#pragma unroll
        for (int n2 = 0; n2 < 2; ++n2) { const int n = 16 * (2 * wave + n2) + sub; bg[n2] = p.in_(I_BGLU)[layer * 256 + n]; onw[n2] = p.in_(I_ON)[layer * DM + 512 + n]; }
#pragma unroll
        for (int mt = 0; mt < 4; ++mt)
#pragma unroll
            for (int r = 0; r < 4; ++r) {
                float ss = 0.f;
#pragma unroll
                for (int n2 = 0; n2 < 2; ++n2) { const float gg = bf2f(Gs[(16 * mt + 4 * q + r) * 264 + 16 * (2 * wave + n2) + sub]); const float o = gg * sigm(z[n2][mt][r] + bg[n2]); gk[n2][mt][r] = o; ss += o * o; }
                ss = sum16(ss);
                if (sub == 0) rowss[wave * 64 + 16 * mt + 4 * q + r] = ss;
            }
        __syncthreads();
        bf16_t* O = (bf16_t*)(p.ws + W_O);
#pragma unroll
        for (int mt = 0; mt < 4; ++mt)
#pragma unroll
            for (int r = 0; r < 4; ++r) {
                const int t = 16 * mt + 4 * q + r;
                float rs = 0.f;
#pragma unroll
                for (int w8 = 0; w8 < 8; ++w8) rs += rowss[w8 * 64 + t];
                const float rinv = rsqrtf(rs * (1.f / 256.f) + EPS);
#pragma unroll
                for (int n2 = 0; n2 < 2; ++n2) O[(size_t)(row0 + t) * DM + 512 + 16 * (2 * wave + n2) + sub] = f2bf(gk[n2][mt][r] * rinv * onw[n2]);
            }
    }
    __syncthreads();
}

template <bool SAMPLE, bool PASS2>
DI void lru_item(const PV& p, int layer, int item, LAS unsigned char* lds) {
    const int tid = p.tid, wave = tid >> 6, lane = tid & 63, sub = lane & 15, q = lane >> 4;
    int row0, b = 0, c = 0;
    if (SAMPLE) row0 = NP + item * 64; else { b = item >> 6; c = item & 63; row0 = b * 4096 + c * 64; }
    const float* XR = (const float*)(p.ws + W_XR); const float* YG = (const float*)(p.ws + W_YG);
    float* LAG = (float*)(p.ws + W_LAG);
    LAS float* XcF = (LAS float*)lds;
    LAS bf16_t* XcB = (LAS bf16_t*)(XcF + 64 * 256);
    LAS float* rowss = (LAS float*)(XcB + 64 * 264);
    const float* cw = p.in_(I_LCW) + layer * 4 * 256; const float* cb = p.in_(I_LCB) + layer * 256;
    for (int i = tid; i < 64 * 256; i += 512) {
        const int t = i >> 8, ch = i & 255, row = row0 + t;
        float acc = cb[ch];
#pragma unroll
        for (int j = 0; j < 4; ++j) {
            float v;
            if (SAMPLE) {
                const int ts = row & 3, idx = ts + j, sq = (row - NP) >> 2;
                v = idx < 3 ? p.in_(I_SLC)[((size_t)(layer * 128 + sq) * 3 + idx) * 256 + ch] : XR[(size_t)(row - ts + idx - 3) * 256 + ch];
            } else {
                const int sidx = c * 64 + t + j - 3;
                v = sidx >= 0 ? XR[(size_t)(b * 4096 + sidx) * 256 + ch] : 0.f;
            }
            acc += cw[j * 256 + ch] * v;
        }
        XcF[i] = acc; XcB[t * 264 + ch] = f2bf(acc);
    }
    if (PASS2) { if (tid < 64) rowss[tid] = 0.f; }
    __syncthreads();
    const int blk = wave >> 1;
    bf16x8 Bfa[2][2], Bfi[2][2];
    float ba[2], bi[2], sp[2], hin[2], aagg[2], onw[2];
    float ok[2][4][4];
#pragma unroll
    for (int ci = 0; ci < 2; ++ci) {
        const int ch = 32 * wave + 16 * ci + sub, jc = ch - 64 * blk;
#pragma unroll
        for (int s = 0; s < 2; ++s) {
            const float* sa = p.in_(I_LWA) + ((size_t)(layer * 4 + blk) * 64 + 32 * s + 8 * q) * 64 + jc;
            const float* si = p.in_(I_LWI) + ((size_t)(layer * 4 + blk) * 64 + 32 * s + 8 * q) * 64 + jc;
            Bfa[ci][s] = pack8((f32x4){sa[0], sa[64], sa[128], sa[192]}, (f32x4){sa[256], sa[320], sa[384], sa[448]});
            Bfi[ci][s] = pack8((f32x4){si[0], si[64], si[128], si[192]}, (f32x4){si[256], si[320], si[384], si[448]});
        }
        ba[ci] = p.in_(I_LBA)[layer * 256 + ch]; bi[ci] = p.in_(I_LBI)[layer * 256 + ch];
        sp[ci] = log1pf(expf(-p.in_(I_LAM)[layer * 256 + ch]));
        onw[ci] = p.in_(I_ON)[layer * DM + 768 + ch];
        hin[ci] = 0.f; aagg[ci] = 1.f;
        if (PASS2 && !SAMPLE) {
            float h = 0.f;
#pragma unroll 1
            for (int j0 = 0; j0 < c; j0 += 8) {
                float la[8], ls[8];
#pragma unroll
                for (int u = 0; u < 8; ++u) { const int jj = (j0 + u < c) ? j0 + u : c - 1; la[u] = LAG[((size_t)(b * 64 + jj) * 2 + 0) * 256 + ch]; ls[u] = LAG[((size_t)(b * 64 + jj) * 2 + 1) * 256 + ch]; }
#pragma unroll
                for (int u = 0; u < 8; ++u) if (j0 + u < c) h = la[u] * h + ls[u];
            }
            hin[ci] = h;
        }
    }
#pragma unroll
    for (int tt = 0; tt < 4; ++tt) {
        bf16x8 Af[2];
#pragma unroll
        for (int s = 0; s < 2; ++s) Af[s] = *(const LAS bf16x8*)(XcB + (16 * tt + sub) * 264 + 64 * blk + 32 * s + 8 * q);
#pragma unroll
        for (int ci = 0; ci < 2; ++ci) {
            const int ch = 32 * wave + 16 * ci + sub;
            f32x4 Ra = {0.f, 0.f, 0.f, 0.f}, Ri = Ra;
#pragma unroll
            for (int s = 0; s < 2; ++s) { Ra = MFMA16(Af[s], Bfa[ci][s], Ra); Ri = MFMA16(Af[s], Bfi[ci][s], Ri); }
            float av[4], bv[4];
#pragma unroll
            for (int r = 0; r < 4; ++r) {
                const int t = 16 * tt + 4 * q + r;
                const float xc = XcF[t * 256 + ch];
                const float rg = sigm(Ra[r] + ba[ci]), ig = sigm(Ri[r] + bi[ci]);
                const float la = -8.f * rg * sp[ci];
                av[r] = __expf(la);
                float mult = sqrtf(-expm1f(2.f * la));
                if (!SAMPLE && c == 0 && t == 0) mult = 1.f;
                bv[r] = mult * ig * xc;
            }
            float in;
            if (SAMPLE) {
                const int sq = (row0 - NP) / 4 + 4 * tt + q;
                in = p.in_(I_SLH)[(size_t)(layer * 128 + sq) * 256 + ch];
            } else {
                float x = bv[0]; x = av[1] * x + bv[1]; x = av[2] * x + bv[2]; x = av[3] * x + bv[3];
                const float P = av[0] * av[1] * av[2] * av[3];
                float e[4], Pk[4];
#pragma unroll
                for (int k = 0; k < 4; ++k) { e[k] = __shfl(x, sub + 16 * k); Pk[k] = __shfl(P, sub + 16 * k); }
                const float E0 = Pk[0] * hin[ci] + e[0], E1 = Pk[1] * E0 + e[1], E2 = Pk[2] * E1 + e[2], E3 = Pk[3] * E2 + e[3];
                in = q == 0 ? hin[ci] : (q == 1 ? E0 : (q == 2 ? E1 : E2));
                hin[ci] = E3; aagg[ci] *= Pk[0] * Pk[1] * Pk[2] * Pk[3];
            }
            if (PASS2) {
                float h = in;
#pragma unroll
                for (int r = 0; r < 4; ++r) {
                    const int t = 16 * tt + 4 * q + r;
                    h = av[r] * h + bv[r];
                    ok[ci][tt][r] = h * gelu_t(YG[(size_t)(row0 + t) * 256 + ch]);
                }
                if (SAMPLE) { const int sq = (row0 - NP) / 4 + 4 * tt + q; p.out[O_SLH + (size_t)(layer * 128 + sq) * 256 + ch] = h; }
            }
        }
        if (PASS2) {
#pragma unroll
            for (int r = 0; r < 4; ++r) {
                float ss = ok[0][tt][r] * ok[0][tt][r] + ok[1][tt][r] * ok[1][tt][r];
                ss = sum16(ss);
                if (sub == 0) rowss[wave * 64 + 16 * tt + 4 * q + r] = ss;
            }
        }
    }
    if (!SAMPLE && q == 0) {
#pragma unroll
        for (int ci = 0; ci < 2; ++ci) {
            const int ch = 32 * wave + 16 * ci + sub;
            if (!PASS2) { LAG[((size_t)(b * 64 + c) * 2 + 0) * 256 + ch] = aagg[ci]; LAG[((size_t)(b * 64 + c) * 2 + 1) * 256 + ch] = hin[ci]; }
            else if (c == 63) p.out[O_PLH + (size_t)(layer * 4 + b) * 256 + ch] = hin[ci];
        }
    }
    if (PASS2) {
        __syncthreads();
        bf16_t* O = (bf16_t*)(p.ws + W_O);
#pragma unroll
        for (int tt = 0; tt < 4; ++tt)
#pragma unroll
            for (int r = 0; r < 4; ++r) {
                const int t = 16 * tt + 4 * q + r;
                float rs = 0.f;
#pragma unroll
                for (int w8 = 0; w8 < 8; ++w8) rs += rowss[w8 * 64 + t];
                const float rinv = rsqrtf(rs * (1.f / 256.f) + EPS);
#pragma unroll
                for (int ci = 0; ci < 2; ++ci) O[(size_t)(row0 + t) * DM + 768 + 32 * wave + 16 * ci + sub] = f2bf(ok[ci][tt][r] * rinv * onw[ci]);
            }
    }
    __syncthreads();
}

DI void l2_evict(const float* wup0, unsigned char* ws0, int wv0) {
    const int tid = wv0 * 64 + (int)__builtin_amdgcn_mbcnt_hi(~0u, __builtin_amdgcn_mbcnt_lo(~0u, 0u));
    const u32x4* src = (const u32x4*)wup0 + (size_t)blockIdx.x * (EVICT_KB * 64);
    u32x4 a = {0u, 0u, 0u, 0u};
#pragma unroll 1
    for (int i = tid; i < EVICT_KB * 64; i += 2048) { const u32x4 v0 = src[i], v1 = src[i + 512], v2 = src[i + 1024], v3 = src[i + 1536]; a.x ^= v0.x ^ v1.x ^ v2.x ^ v3.x; a.y ^= v0.y ^ v1.y ^ v2.y ^ v3.y; a.z ^= v0.z ^ v1.z ^ v2.z ^ v3.z; a.w ^= v0.w ^ v1.w ^ v2.w ^ v3.w; }
    if ((a.x ^ a.y ^ a.z ^ a.w) == 0x9e3779b9u && a.x == 0x12345u) ws0[W_END - 1] = 1;
}
#define GSYNC() do { if (P.ph_hi - P.ph_lo <= 1) break; grid.sync(); } while (0)
#define MAKE_PV() \
    unsigned _wl = (unsigned)(unsigned long long)P.ws, _wh = (unsigned)((unsigned long long)P.ws >> 32), _ol = (unsigned)(unsigned long long)P.out, _oh = (unsigned)((unsigned long long)P.out >> 32); \
    int z = 0, bidx = blockIdx.x, nbx = gridDim.x; \
    asm volatile("" : "+v"(_wl), "+v"(_wh), "+v"(_ol), "+v"(_oh), "+v"(z), "+v"(bidx), "+v"(nbx)); \
    _wl = __builtin_amdgcn_readfirstlane(_wl); _wh = __builtin_amdgcn_readfirstlane(_wh); _ol = __builtin_amdgcn_readfirstlane(_ol); _oh = __builtin_amdgcn_readfirstlane(_oh); \
    z = __builtin_amdgcn_readfirstlane(z); bidx = __builtin_amdgcn_readfirstlane(bidx); nbx = __builtin_amdgcn_readfirstlane(nbx); \
    unsigned char* ws = (unsigned char*)(((unsigned long long)_wh << 32) | _wl); float* outp = (float*)(((unsigned long long)_oh << 32) | _ol); \
    int tidx = wv0 * 64 + (int)__builtin_amdgcn_mbcnt_hi(~0u, __builtin_amdgcn_mbcnt_lo(~0u, 0u)); asm volatile("" : "+v"(tidx)); \
    const PV p{P, z, outp, ws, tidx, bidx, nbx}; \
    float* X = outp + O_YP; float* MOD = (float*)(ws + W_MOD); (void)X; (void)MOD;

template <int l>
DI void layer_phases(const Params& P, LAS unsigned char* lds, cg::grid_group& grid, const int wv0, const float* wup0, unsigned char* ws0) {
    {   MAKE_PV();
        constexpr int le = l;
        const float* xp = le == 0 ? p.in_(I_XP) : X; const float* xs_adj = le == 0 ? p.in_(I_XS) - (size_t)NP * DM : X;
        if (EN(0) && ORD(2 + 9 * l + 0)) phase_norm(p, xp, xs_adj, p.in_(I_NORM1) + le * DM, MOD + le * NMOD, (bf16_t*)(ws + W_H));
    }
    GSYNC();
    {   MAKE_PV();
        EpiIn E; E.layer = l; E.Q = (bf16_t*)(ws + W_Q); E.Kb = (bf16_t*)(ws + W_KB); E.Vb = (bf16_t*)(ws + W_VB);
        E.U = (float*)(ws + W_U); E.XR = (float*)(ws + W_XR); E.YG = (float*)(ws + W_YG);
        E.qn = p.in_(I_QN); E.kn = p.in_(I_KN); E.rotc = (const float*)(ws + W_ROTC); E.rots = (const float*)(ws + W_ROTS); E.out = outp;
        if (EN(1) && ORD(2 + 9 * l + 1)) run_gemm(p, lds, (const bf16_t*)(ws + W_H), (const bf16_t*)(ws + W_WTIN) + (size_t)l * DIN * DM, NTOK, DIN, DM, E);
    }
    GSYNC();
    {   int bid0 = blockIdx.x, nb0 = gridDim.x; asm volatile("" : "+v"(bid0), "+v"(nb0)); bid0 = __builtin_amdgcn_readfirstlane(bid0); nb0 = __builtin_amdgcn_readfirstlane(nb0);
#pragma unroll 1
        for (int it = bid0; it < 2048 + 768; it += nb0) {
            MAKE_PV();
            if (it < 2048) { if (EN(20) && ORD(2 + 9 * l + 2)) attn_prompt16_item(p, l, it, lds); }
            else if (it < 2048 + 256) { if (EN(21) && ORD(2 + 9 * l + 2)) attn_sample_item(p, l, it - 2048, lds); }
            else if (it < 2048 + 512) { if (EN(22) && ORD(2 + 9 * l + 2) && ((it - 2048 - 256) & 63) != 63) ssm_item<false, false>(p, l, it - 2048 - 256, lds); }
            else { if (EN(23) && ORD(2 + 9 * l + 2) && ((it - 2048 - 512) & 63) != 63) lru_item<false, false>(p, l, it - 2048 - 512, lds); }
        }
    }
    GSYNC();
    {   int bid0 = blockIdx.x, nb0 = gridDim.x; asm volatile("" : "+v"(bid0), "+v"(nb0)); bid0 = __builtin_amdgcn_readfirstlane(bid0); nb0 = __builtin_amdgcn_readfirstlane(nb0);
#pragma unroll 1
        for (int it = bid0; it < 594; it += nb0) {
            MAKE_PV();
            if (it < 256) { if (EN(30) && ORD(2 + 9 * l + 3)) ssm_item<false, true>(p, l, it, lds); }
            else if (it < 512) { if (EN(31) && ORD(2 + 9 * l + 3)) lru_item<false, true>(p, l, it - 256, lds); }
            else if (it < 520) { if (EN(32) && ORD(2 + 9 * l + 3)) ssm_item<true, true>(p, l, it - 512, lds); }
            else if (it < 528) { if (EN(33) && ORD(2 + 9 * l + 3)) lru_item<true, true>(p, l, it - 520, lds); }
            else { if (EN(34) && ORD(2 + 9 * l + 3)) attn_norm_item(p, l, it - 528); }
        }
    }
    GSYNC();
    {   MAKE_PV();
        const float* xp = l == 0 ? p.in_(I_XP) : X; const float* xs_adj = l == 0 ? p.in_(I_XS) - (size_t)NP * DM : X;
        EpiRes E; E.xp = xp; E.xs_adj = xs_adj; E.X = X; E.MODg = MOD + l * NMOD + 2048;
        if (EN(4) && ORD(2 + 9 * l + 4)) run_gemm(p, lds, (const bf16_t*)(ws + W_O), (const bf16_t*)(ws + W_WTO) + (size_t)l * DM * DM, NTOK, DM, DM, E);
    }
    GSYNC();
    {   MAKE_PV();
        if (EN(5) && ORD(2 + 9 * l + 5)) phase_norm(p, X, X, p.in_(I_NORM2) + l * DM, MOD + l * NMOD + 3072, (bf16_t*)(ws + W_H2));
    }
    GSYNC();
    {   MAKE_PV();
        EpiUp E; E.layer = l; E.UP = (bf16_t*)(ws + W_UP); E.out = outp;
        if (EN(6) && ORD(2 + 9 * l + 6)) run_gemm(p, lds, (const bf16_t*)(ws + W_H2), (const bf16_t*)(ws + W_WTUP) + (size_t)l * DUP * DM, NTOK, DUP, DM, E);
    }
    GSYNC();
    {   MAKE_PV();
        if (EN(7) && ORD(2 + 9 * l + 7)) phase_convglu(p, l);
    }
    GSYNC();
    {   MAKE_PV();
        EpiRes E; E.xp = X; E.xs_adj = X; E.X = X; E.MODg = MOD + l * NMOD + 5120;
        if (EN(8) && ORD(2 + 9 * l + 8)) run_gemm(p, lds, (const bf16_t*)(ws + W_ACT), (const bf16_t*)(ws + W_WTDN) + (size_t)l * DM * DFF, NTOK, DM, DFF, E);
    }
}

__global__ void __launch_bounds__(512) hymba_mega(Params P) {
    extern __shared__ __attribute__((aligned(16))) unsigned char shm[];
    LAS unsigned char* lds = (LAS unsigned char*)shm;
    cg::grid_group grid = cg::this_grid();
    const int wv0 = __builtin_amdgcn_readfirstlane((int)(threadIdx.x >> 6));
    const float* wup0 = P.in[I_WUP]; unsigned char* ws0 = P.ws;
    {   MAKE_PV();
        if (EN(100) && ORD(0)) phase_prologue(p, lds);
    }
    GSYNC();
    {   MAKE_PV();
        EpiAda E; E.MOD = MOD; E.bias = p.in_(I_BADA);
        if (EN(101) && ORD(1)) run_gemm(p, lds, (const bf16_t*)(ws + W_CSILU), (const bf16_t*)(ws + W_WTADA), 256, NMODALL, DM, E);
    }
    GSYNC();
    layer_phases<0>(P, lds, grid, wv0, wup0, ws0);
    GSYNC();
    layer_phases<1>(P, lds, grid, wv0, wup0, ws0);
    GSYNC();
    layer_phases<2>(P, lds, grid, wv0, wup0, ws0);
    GSYNC();
    layer_phases<3>(P, lds, grid, wv0, wup0, ws0);
#ifdef STALE_TEST
    {
        float* T = (float*)(P.ws + W_UP); unsigned* cnt = (unsigned*)(P.ws + W_ACT);
        const int tid = wv0 * 64 + (int)__builtin_amdgcn_mbcnt_hi(~0u, __builtin_amdgcn_mbcnt_lo(~0u, 0u));
        const size_t n = (size_t)16 * 1024 * 1024, per = n / gridDim.x;
        if (blockIdx.x == 0 && tid < 8) cnt[tid] = 0u;
        for (int rep = 0; rep < 4; ++rep) {
            const float val = (float)(rep + 1);
            for (size_t i = (size_t)blockIdx.x * per + tid; i < (size_t)(blockIdx.x + 1) * per; i += 512) T[i] = val;
            GSYNC();
            const int rb = (blockIdx.x + 3 + rep) % gridDim.x; unsigned bad = 0;
            for (size_t i = (size_t)rb * per + tid; i < (size_t)(rb + 1) * per; i += 512) bad += (T[i] != val) ? 1u : 0u;
            if (bad) atomicAdd(cnt + rep, bad);
            GSYNC();
        }
        float* X = P.out + O_YP;
        for (size_t i = (size_t)blockIdx.x * 512 + tid; i < (size_t)NTOK * DM; i += (size_t)gridDim.x * 512) X[i] = (i < 4) ? 1000.f + (float)cnt[i] : 0.f;
    }
#endif
#ifdef DIAG2
    if (ORD(40)) {   MAKE_PV();
        const u32x4* src = (const u32x4*)(ws + DIAG_OFF); u32x4* dst = (u32x4*)(ws + W_ACT);
        for (size_t i = (size_t)bidx * 512 + tidx; i < (size_t)DIAG_BYTES / 16; i += (size_t)nbx * 512) dst[i] = src[i];
        if (bidx == 0 && tidx == 0) *(unsigned*)(ws + W_ACT + 64 * 1024 * 1024) = 0u;
    }
    if (ORD(41)) {   MAKE_PV();
        const bf16_t* a = (const bf16_t*)(ws + DIAG_OFF); const bf16_t* b = (const bf16_t*)(ws + W_ACT); float mx = 0.f;
        for (size_t i = (size_t)bidx * 512 + tidx; i < (size_t)DIAG_BYTES / 2; i += (size_t)nbx * 512) mx = fmaxf(mx, fabsf(bf2f(a[i]) - bf2f(b[i])));
        atomicMax((unsigned*)(ws + W_ACT + 64 * 1024 * 1024), __float_as_uint(mx));
    }
    if (ORD(42)) {   MAKE_PV();
        const float mx = __uint_as_float(*(const unsigned*)(ws + W_ACT + 64 * 1024 * 1024));
        for (size_t i = (size_t)bidx * 512 + tidx; i < (size_t)NTOK * DM; i += (size_t)nbx * 512) X[i] = (i == 0) ? 1000.f + 1.0e6f * mx : 0.f;
    }
#endif
#ifdef DUMP_OFF
    GSYNC();
    if (ORD(38)) {   MAKE_PV();
        const bf16_t* Qd = (const bf16_t*)(ws + W_Q); const bf16_t* Kd = (const bf16_t*)(ws + W_KB); const bf16_t* Vd = (const bf16_t*)(ws + W_VB);
        const float* OA = (const float*)(ws + W_OATT);
        for (size_t i = (size_t)bidx * 512 + tidx; i < (size_t)NTOK * DM; i += (size_t)nbx * 512) {
            const int c = (int)(i & 1023); const size_t row = i >> 10; float v = 0.f;
            if (DUMP_MODE == 3) { { if (c < 512) v = 4096.f * bf2f(Qd[row * 512 + c]); else if (c < 640) v = 512.f * bf2f(Kd[row * 128 + c - 512]); else if (c < 768) v = 512.f * bf2f(Vd[row * 128 + c - 640]); } }
            if (DUMP_MODE == 8) { v = 4096.f * X[i]; }
            if (DUMP_MODE == 2) { if (c < 512 && row < NP) v = 4096.f * OA[row * 512 + c]; }
            if (DUMP_MODE == 7) { const float* Ud = (const float*)(ws + W_U); const float* XRd = (const float*)(ws + W_XR); const float* YGd = (const float*)(ws + W_YG); if (c < 256) v = 4096.f * Ud[row * 256 + c]; else if (c < 512) v = 4096.f * XRd[row * 256 + c - 256]; else if (c < 768) v = 4096.f * YGd[row * 256 + c - 512]; }
            if (DUMP_MODE == 9) { const bf16_t* Od = (const bf16_t*)(ws + W_O); v = 256.f * bf2f(Od[i]); }
            if (DUMP_MODE == 6) { const bf16_t* Hd = (const bf16_t*)(ws + W_H); v = 64.f * bf2f(Hd[i]); }
            if (DUMP_MODE == 5) { const bf16_t* Wd = (const bf16_t*)(ws + W_WTIN); if (i < (size_t)4 * DIN * DM + (size_t)4 * DM * DM) v = 256.f * bf2f(Wd[i]); }
            X[i] = v; }
    }
#endif
}

constexpr int N_PHASES = 2 + 9 * DEPTH;

extern "C" void kernel_launch(void* const* d_in, const int* in_sizes, int n_in, void* d_out, int out_size, void* d_ws, size_t ws_size, hipStream_t stream) {
    static int grid = 0;
    if (grid == 0) {
        if (n_in != N_IN || (size_t)out_size != O_END || ws_size < W_END) {
            fprintf(stderr, "kernel_launch: unexpected sizes n_in %d out %d ws %zu (need %zu)\n", n_in, out_size, ws_size, (size_t)W_END); grid = -1; return; }
        int dev = 0, cus = 0, per_cu = 0;
        (void)hipGetDevice(&dev);
        (void)hipDeviceGetAttribute(&cus, hipDeviceAttributeMultiprocessorCount, dev);
        if (hipFuncSetAttribute((const void*)hymba_mega, hipFuncAttributeMaxDynamicSharedMemorySize, LDS_BYTES) != hipSuccess) { fprintf(stderr, "kernel_launch: hipFuncSetAttribute failed\n"); grid = -1; return; }
        if (hipOccupancyMaxActiveBlocksPerMultiprocessor(&per_cu, (const void*)hymba_mega, 512, LDS_BYTES) != hipSuccess || per_cu < 1) { fprintf(stderr, "kernel_launch: occupancy query failed (%d)\n", per_cu); (void)hipGetLastError(); per_cu = 1; }
        grid = cus * per_cu;
    }
    if (grid < 0) return;
    Params p{};
    for (int i = 0; i < N_IN; ++i) p.in[i] = (const float*)d_in[i];
    p.out = (float*)d_out; p.ws = (unsigned char*)d_ws;
#if MULTI_LAUNCH
    const int olist[] = {0, 1, 2, 40, 2, 41, 42};
    for (int oi = 0; oi < (int)(sizeof(olist) / sizeof(int)); ++oi) {
        const int o = olist[oi];
        p.ph_lo = o; p.ph_hi = o + 1;
        hipLaunchKernelGGL(hymba_mega, dim3(grid), dim3(512), LDS_BYTES, stream, p);
    }
#else
    p.ph_lo = 0; p.ph_hi = N_PHASES;
    void* args[] = {&p};
    hipError_t e = hipLaunchCooperativeKernel((const void*)hymba_mega, dim3(grid), dim3(512), args, LDS_BYTES, stream);
    if (e != hipSuccess) fprintf(stderr, "cooperative launch failed: %s (grid %d)\n", hipGetErrorString(e), grid);
#endif
}
```
